# Optimizing an MI355X kernel written in HIP

```python
import jax, jax.numpy as jnp
from jax import lax
import numpy as np

D_MODEL = 2048
BATCH = 4
SEQ = 4096
DEPTH = 4

N_MIXERS = 2
N_POOL_LAYERS = (DEPTH + 1) // 2
N_FOX_LAYERS = DEPTH // 2

POOL_WINDOWS = (2, 4, 8, 16)
N_POOL_GROUPS = len(POOL_WINDOWS)
POOL_GROUP = D_MODEL // N_POOL_GROUPS

HEAD_DIM = 64
N_HEADS = D_MODEL // HEAD_DIM
Q_BLOCK = 128
ATTN_SCALE = HEAD_DIM ** -0.5
FOX_IN = 4 * D_MODEL + N_HEADS

FFN_HIDDEN = ((8 * D_MODEL // 3 + 255) // 256) * 256

RMS_EPS = 1e-6

kernel_name = "hybrid_pool_fox_swiglu_trunk"


def rmsnorm(x, g):
    xf = x.astype(jnp.float32)
    y = xf * lax.rsqrt(jnp.mean(xf * xf, axis=-1, keepdims=True) + RMS_EPS)
    return (y * g.astype(jnp.float32)).astype(x.dtype)


def pool_mixer(h, w_group, scale):
    B, S, D = h.shape
    hf = h.astype(jnp.float32)
    cs = jnp.cumsum(hf, axis=1)
    n_valid = jnp.arange(1, S + 1, dtype=jnp.float32)[:, None]
    feats = []
    for g, win in enumerate(POOL_WINDOWS):
        sl = slice(g * POOL_GROUP, (g + 1) * POOL_GROUP)
        cg = cs[..., sl]
        prev = jnp.pad(cg, ((0, 0), (win, 0), (0, 0)))[:, :S]
        mean = (cg - prev) / jnp.minimum(n_valid, float(win))
        feats.append(mean - hf[..., sl])
    f = jnp.stack(feats, axis=2).astype(h.dtype)
    y = jnp.einsum('bsgc,gcd->bsgd', f, w_group).reshape(B, S, D)
    return y * scale


def fox_mixer(h, w_in, b_f, q_norm_g, k_norm_g, w_out):
    B, S, D = h.shape
    proj = h @ w_in
    q = rmsnorm(proj[..., 0 * D:1 * D].reshape(B, S, N_HEADS, HEAD_DIM), q_norm_g)
    k = rmsnorm(proj[..., 1 * D:2 * D].reshape(B, S, N_HEADS, HEAD_DIM), k_norm_g)
    v = proj[..., 2 * D:3 * D].reshape(B, S, N_HEADS, HEAD_DIM)
    og = proj[..., 3 * D:4 * D]
    log_f = jax.nn.log_sigmoid(proj[..., 4 * D:].astype(jnp.float32) + b_f.astype(jnp.float32))
    c = jnp.transpose(jnp.cumsum(log_f, axis=1), (0, 2, 1))
    outs = []
    for i in range(S // Q_BLOCK):
        qs, qe = i * Q_BLOCK, (i + 1) * Q_BLOCK
        s = jnp.einsum('bqhd,bkhd->bhqk', q[:, qs:qe], k[:, :qe],
                       preferred_element_type=jnp.float32) * ATTN_SCALE
        s = s + c[:, :, qs:qe, None] - c[:, :, None, :qe]
        causal = jnp.arange(qs, qe)[:, None] >= jnp.arange(qe)[None, :]
        s = jnp.where(causal, s, -jnp.inf)
        p = jax.nn.softmax(s, axis=-1).astype(v.dtype)
        outs.append(jnp.einsum('bhqk,bkhd->bqhd', p, v[:, :qe]))
    o = jnp.concatenate(outs, axis=1).reshape(B, S, D)
    o = o * jax.nn.sigmoid(og)
    return o @ w_out


def swiglu(h, w_gate_up, w_down):
    gu = h @ w_gate_up
    gate, up = gu[..., :FFN_HIDDEN], gu[..., FFN_HIDDEN:]
    return (jax.nn.silu(gate) * up) @ w_down


def setup_inputs(seed: int = 0) -> dict:
    key = jax.random.key(seed)
    ks = jax.random.split(key, 16)
    f32 = jnp.float32
    D = D_MODEL

    def nrm(k, shape, fan_in):
        return jax.random.normal(k, shape, f32) * (fan_in ** -0.5)

    def gain(k, shape):
        return 1.0 + 0.05 * jax.random.normal(k, shape, f32)

    return {
        "x": jax.random.normal(ks[0], (BATCH, SEQ, D), f32),
        "attn_norm_g": gain(ks[1], (DEPTH, D)),
        "ffn_norm_g": gain(ks[2], (DEPTH, D)),
        "final_norm_g": gain(ks[3], (D,)),
        "pool_w": nrm(ks[4], (N_POOL_LAYERS, N_POOL_GROUPS, POOL_GROUP, POOL_GROUP), POOL_GROUP),
        "pool_scale": gain(ks[5], (N_POOL_LAYERS, D)),
        "fox_w_in": nrm(ks[6], (N_FOX_LAYERS, D, FOX_IN), D),
        "fox_b_f": jax.random.uniform(ks[7], (N_FOX_LAYERS, N_HEADS), f32, minval=1.0, maxval=5.0),
        "fox_q_norm_g": gain(ks[8], (N_FOX_LAYERS, HEAD_DIM)),
        "fox_k_norm_g": gain(ks[9], (N_FOX_LAYERS, HEAD_DIM)),
        "fox_w_out": nrm(ks[10], (N_FOX_LAYERS, D, D), D),
        "ffn_w_gate_up": nrm(ks[11], (DEPTH, D, 2 * FFN_HIDDEN), D),
        "ffn_w_down": nrm(ks[12], (DEPTH, FFN_HIDDEN, D), FFN_HIDDEN),
    }


def reference(x, attn_norm_g, ffn_norm_g, final_norm_g, pool_w, pool_scale,
              fox_w_in, fox_b_f, fox_q_norm_g, fox_k_norm_g, fox_w_out,
              ffn_w_gate_up, ffn_w_down):
    h = x
    for i in range(DEPTH):
        hn = rmsnorm(h, attn_norm_g[i])
        j = i // N_MIXERS
        if i % N_MIXERS == 0:
            mix = pool_mixer(hn, pool_w[j], pool_scale[j])
        else:
            mix = fox_mixer(hn, fox_w_in[j], fox_b_f[j], fox_q_norm_g[j],
                            fox_k_norm_g[j], fox_w_out[j])
        h = h + mix
        h = h + swiglu(rmsnorm(h, ffn_norm_g[i]), ffn_w_gate_up[i], ffn_w_down[i])
    return rmsnorm(h, final_norm_g)
```

```cpp
#include <hip/hip_runtime.h>
#include <hip/hip_cooperative_groups.h>
#include <hip/hip_bf16.h>
#include <cstdio>
#include <cstdint>
#include <cmath>
namespace cg = cooperative_groups;

constexpr int BATCH = 4, SEQ = 4096, DM = 2048, M = BATCH * SEQ, NH = 32, HD = 64, FF = 5632, NGU = 2 * FF, NIN = 4 * DM + NH, NIN_PAD = 8448, PG = 512;
constexpr float RMS_EPS = 1e-6f;

namespace pg8 {
#define PG8_LAS __attribute__((address_space(3)))
typedef unsigned short bf16_t;
typedef short bf16x8 __attribute__((ext_vector_type(8)));
typedef float f32x4 __attribute__((ext_vector_type(4)));
typedef unsigned u32x4 __attribute__((ext_vector_type(4)));
constexpr int BM = 256, BK = 64, HALF = 128, HTB = HALF * BK * 2  , STAGE_BYTES = 8 * HTB, NXCD = 8, WGM = 8;

__host__ __device__ __forceinline__ int lds_byte(int r, int c) { const int st = (r >> 4) * 2 + (c >> 5), rr = r & 15, cc = c & 31, ob = rr * 64 + cc * 2; return st * 1024 + (ob ^ (((ob >> 9) & 1) << 5)); }
__host__ __device__ __forceinline__ void stage_rc(int b, int& R, int& C) { const int st = b / 1024, sb = b % 1024, swz = sb ^ (((sb >> 9) & 1) << 5); R = (st >> 1) * 16 + swz / 64; C = (st & 1) * 32 + (swz % 64) / 2; }
__host__ __device__ __forceinline__ int perm32(int rho) { const int n = rho >> 4, i = rho & 15; return 8 * (i >> 2) + 4 * n + (i & 3); }

struct Unit { int pm, pn; };
struct Gemm { const bf16_t* A; const bf16_t* Bt; int M, N, K, lda, gdiv; };

struct StaticOrder {
    int nM, nN, nwg, G, c;
    __host__ __device__ void init(int M_, int N_, int G_, int c_) { nM = M_ / BM; nN = N_ / BM; nwg = nM * nN; G = G_; c = c_; }
    __host__ __device__ bool next(int i, Unit& u) const {
        const long L = (long)i * G + c; if (L >= nwg) return false;
        int wgid = (int)L; { const int q = nwg / NXCD, r = nwg % NXCD, xcd = wgid % NXCD, off = wgid / NXCD; wgid = (xcd < r ? xcd * (q + 1) : r * (q + 1) + (xcd - r) * q) + off; }
        const int nig = WGM * nN, gid = wgid / nig, fm = gid * WGM, gsz = (nM - fm) < WGM ? (nM - fm) : WGM;
        u.pm = fm + ((wgid % nig) % gsz); u.pn = (wgid % nig) / gsz; return true;
    }
};

__device__ __forceinline__ unsigned cvt_pk_bf16(float lo, float hi) { unsigned r; asm volatile("v_cvt_pk_bf16_f32 %0, %1, %2" : "=v"(r) : "v"(lo), "v"(hi)); return r; }
__device__ __forceinline__ float rstd_row(const float* ssq, int row) { return rsqrtf(ssq[row] * (1.0f / (float)DM) + RMS_EPS); }
__device__ __forceinline__ float sigmoid_f(float v) { return __builtin_amdgcn_rcpf(1.0f + __builtin_amdgcn_exp2f(-1.4426950408889634f * v)); }

struct EpiFoxIn {
    static constexpr bool PERM = true;
    bf16_t* QKVG; size_t tstride;
    float* logf; const float* ssq; const float* bf; const float* gq; const float* gk; float qscale;
    __device__ __forceinline__ void operator()(const f32x4 (&acc)[2][2][4][2], const Unit& u, int wr, int wc, int fr, int fq) const {
        const int row0 = u.pm * BM + wr * 64 + fr;
        if (u.pn == 32) {
            if (wc == 0) {
                f32x4 bv[2];
#pragma unroll
                for (int n = 0; n < 2; ++n) bv[n] = *(const f32x4*)(bf + 8 * fq + 4 * n);
#pragma unroll
                for (int ai = 0; ai < 2; ++ai)
#pragma unroll
                    for (int m = 0; m < 4; ++m) { const int row = row0 + ai * HALF + m * 16; const float rs = rstd_row(ssq, row);
#pragma unroll
                        for (int n = 0; n < 2; ++n) { const f32x4 z = acc[ai][0][m][n] * rs + bv[n]; f32x4 o;
#pragma unroll
                            for (int e = 0; e < 4; ++e) o[e] = fminf(z[e], 0.f) - __logf(1.0f + __expf(-fabsf(z[e])));
                            *(f32x4*)(logf + (size_t)row * NH + 8 * fq + 4 * n) = o; } }
            }
            return;
        }
        const int t = u.pn >> 3, head = (u.pn & 7) * 4 + wc;
        bf16_t* base = QKVG + (size_t)t * tstride + head * HD + 8 * fq;
        f32x4 gv[2][2];
#pragma unroll
        for (int bj = 0; bj < 2; ++bj)
#pragma unroll
            for (int n = 0; n < 2; ++n) { gv[bj][n] = (f32x4){1.f, 1.f, 1.f, 1.f};
                if (t < 2) gv[bj][n] = *(const f32x4*)((t == 0 ? gq : gk) + 32 * bj + 8 * fq + 4 * n) * (t == 0 ? qscale : 1.0f); }
#pragma unroll
        for (int ai = 0; ai < 2; ++ai)
#pragma unroll
            for (int m = 0; m < 4; ++m) { const int row = row0 + ai * HALF + m * 16; const float rs = rstd_row(ssq, row);
                f32x4 v[2][2]; float ss = 0.f;
#pragma unroll
                for (int bj = 0; bj < 2; ++bj)
#pragma unroll
                    for (int n = 0; n < 2; ++n) { v[bj][n] = acc[ai][bj][m][n] * rs; const f32x4 q = v[bj][n] * v[bj][n]; ss += (q[0] + q[1]) + (q[2] + q[3]); }
                if (t < 2) { ss += __shfl_xor(ss, 16); ss += __shfl_xor(ss, 32); const float rn = rsqrtf(ss * (1.0f / (float)HD) + RMS_EPS);
#pragma unroll
                    for (int bj = 0; bj < 2; ++bj)
#pragma unroll
                        for (int n = 0; n < 2; ++n) v[bj][n] = v[bj][n] * rn * gv[bj][n]; }
                if (t == 3) {
#pragma unroll
                    for (int bj = 0; bj < 2; ++bj)
#pragma unroll
                        for (int n = 0; n < 2; ++n)
#pragma unroll
                            for (int e = 0; e < 4; ++e) v[bj][n][e] = sigmoid_f(v[bj][n][e]); }
#pragma unroll
                for (int bj = 0; bj < 2; ++bj) { u32x4 w; w.x = cvt_pk_bf16(v[bj][0][0], v[bj][0][1]); w.y = cvt_pk_bf16(v[bj][0][2], v[bj][0][3]); w.z = cvt_pk_bf16(v[bj][1][0], v[bj][1][1]); w.w = cvt_pk_bf16(v[bj][1][2], v[bj][1][3]);
                    *(u32x4*)(base + (size_t)row * DM + 32 * bj) = w; } }
    }
};

struct EpiSwiglu {
    static constexpr bool PERM = true;
    bf16_t* O; const float* ssq;
    __device__ __forceinline__ void operator()(const f32x4 (&acc)[2][2][4][2], const Unit& u, int wr, int wc, int fr, int fq) const {
        const int row0 = u.pm * BM + wr * 64 + fr, col0 = u.pn * HALF + wc * 32 + 8 * fq;
#pragma unroll
        for (int ai = 0; ai < 2; ++ai)
#pragma unroll
            for (int m = 0; m < 4; ++m) { const int row = row0 + ai * HALF + m * 16; const float rs = rstd_row(ssq, row); f32x4 a[2];
#pragma unroll
                for (int n = 0; n < 2; ++n) { const f32x4 g = acc[ai][0][m][n] * rs, up = acc[ai][1][m][n] * rs;
#pragma unroll
                    for (int e = 0; e < 4; ++e) a[n][e] = g[e] * sigmoid_f(g[e]) * up[e]; }
                u32x4 w; w.x = cvt_pk_bf16(a[0][0], a[0][1]); w.y = cvt_pk_bf16(a[0][2], a[0][3]); w.z = cvt_pk_bf16(a[1][0], a[1][1]); w.w = cvt_pk_bf16(a[1][2], a[1][3]);
                *(u32x4*)(O + (size_t)row * FF + col0) = w; }
    }
};

struct EpiResid {
    static constexpr bool PERM = true;
    const float* base; float* out; bf16_t* hb; float* ssq_out; const float* colscale;
    __device__ __forceinline__ void operator()(const f32x4 (&acc)[2][2][4][2], const Unit& u, int wr, int wc, int fr, int fq) const {
        const int row0 = u.pm * BM + wr * 64 + fr, col0 = u.pn * BM + wc * 32 + 8 * fq;
        f32x4 sc[2][2];
#pragma unroll
        for (int bj = 0; bj < 2; ++bj)
#pragma unroll
            for (int n = 0; n < 2; ++n) sc[bj][n] = colscale ? *(const f32x4*)(colscale + col0 + bj * HALF + 4 * n) : (f32x4){1.f, 1.f, 1.f, 1.f};
#pragma unroll
        for (int ai = 0; ai < 2; ++ai)
#pragma unroll
            for (int m = 0; m < 4; ++m) { const int row = row0 + ai * HALF + m * 16; const size_t off = (size_t)row * DM + col0; float ss = 0.f;
#pragma unroll
                for (int bj = 0; bj < 2; ++bj) { f32x4 o[2];
#pragma unroll
                    for (int n = 0; n < 2; ++n) { o[n] = *(const f32x4*)(base + off + bj * HALF + 4 * n) + acc[ai][bj][m][n] * sc[bj][n];
                        *(f32x4*)(out + off + bj * HALF + 4 * n) = o[n]; const f32x4 q = o[n] * o[n]; ss += (q[0] + q[1]) + (q[2] + q[3]); }
                    if (hb) { u32x4 w; w.x = cvt_pk_bf16(o[0][0], o[0][1]); w.y = cvt_pk_bf16(o[0][2], o[0][3]); w.z = cvt_pk_bf16(o[1][0], o[1][1]); w.w = cvt_pk_bf16(o[1][2], o[1][3]);
                        *(u32x4*)(hb + off + bj * HALF) = w; } }
                ss += __shfl_xor(ss, 16); ss += __shfl_xor(ss, 32);
                if (fq == 0) (void)__hip_atomic_fetch_add(ssq_out + row, ss, __ATOMIC_RELAXED, __HIP_MEMORY_SCOPE_AGENT); }
    }
};

template <class Epi>
__device__ __forceinline__ void gemm_phase(PG8_LAS unsigned char* lds, const Gemm g, const StaticOrder& S, const Epi& E, const int tid) {
    const int wid = __builtin_amdgcn_readfirstlane(tid >> 6), lane = tid & 63, wr = wid >> 2, wc = wid & 3, fr = lane & 15, fq = lane >> 4;
    const int K = g.K, nt = K / BK, lda = g.lda;
    unsigned voffA[2], voffB[2];
#pragma unroll
    for (int i = 0; i < 2; ++i) { int R, C; stage_rc(tid * 16 + i * 8192, R, C); const int Rb = Epi::PERM ? ((R & ~31) + perm32(R & 31)) : R;
        voffA[i] = (unsigned)(R * lda + C) * 2u; voffB[i] = (unsigned)(Rb * K + C) * 2u; }
    const size_t kstep = (size_t)(BK * 2);
    const size_t hsA = (size_t)HALF * lda * 2, hsB = (size_t)HALF * K * 2;
    const size_t tsA = 2 * hsA, tsB = 2 * hsB;
    const size_t gsA = (size_t)K * 2;
    const unsigned ldsw = (unsigned)wid * 1024u;
    const int aoff = lds_byte(wr * 64 + fr, fq * 8), boff = lds_byte(wc * 32 + fr, fq * 8);
#define PG8_UA(u) ((const char*)g.A + (size_t)(u).pm * tsA + (size_t)((u).pn / g.gdiv) * gsA)
#define PG8_UB(u) ((const char*)g.Bt + (size_t)(u).pn * tsB)
#define PG8_SA(b, h) (((b) * 2 + (h)) * HTB)
#define PG8_SB(b, h) ((4 + (b) * 2 + (h)) * HTB)
#define PG8_STAGE(bufoff, gbase, voff) do { _Pragma("unroll") for (int _i = 0; _i < 2; ++_i) \
        __builtin_amdgcn_global_load_lds((const unsigned*)((const char*)(gbase) + (voff)[_i]), (PG8_LAS unsigned*)(lds + (bufoff) + ldsw + _i * 8192), 16, 0, 0); } while (0)
#define PG8_LDA(dst, b, h) do { _Pragma("unroll") for (int m = 0; m < 4; ++m) _Pragma("unroll") for (int k = 0; k < 2; ++k) dst[m][k] = *(const PG8_LAS bf16x8*)(lds + PG8_SA(b, h) + aoff + m * 2048 + k * 1024); } while (0)
#define PG8_LDB(dst, b, h) do { _Pragma("unroll") for (int n = 0; n < 2; ++n) _Pragma("unroll") for (int k = 0; k < 2; ++k) dst[n][k] = *(const PG8_LAS bf16x8*)(lds + PG8_SB(b, h) + boff + n * 2048 + k * 1024); } while (0)
#define PG8_MMA(ai, bj, At, Bt) do { __builtin_amdgcn_s_setprio(1); _Pragma("unroll") for (int m = 0; m < 4; ++m) _Pragma("unroll") for (int n = 0; n < 2; ++n) _Pragma("unroll") for (int k = 0; k < 2; ++k) \
        acc[ai][bj][m][n] = __builtin_amdgcn_mfma_f32_16x16x32_bf16(Bt[n][k], At[m][k], acc[ai][bj][m][n], 0, 0, 0); __builtin_amdgcn_s_setprio(0); } while (0)
#define PG8_WAIT_V(n) asm volatile("s_waitcnt vmcnt(" #n ")" ::: "memory")
#define PG8_WAIT_L(n) asm volatile("s_waitcnt lgkmcnt(" #n ")" ::: "memory")
#define PG8_BAR __builtin_amdgcn_s_barrier()
#define PG8_SCHED __builtin_amdgcn_sched_barrier(0)
    Unit cur, nxt; int ui = 0;
    if (!S.next(0, cur)) return;
    f32x4 acc[2][2][4][2];
#pragma unroll
    for (int a = 0; a < 2; ++a)
#pragma unroll
        for (int b = 0; b < 2; ++b)
#pragma unroll
            for (int m = 0; m < 4; ++m)
#pragma unroll
                for (int n = 0; n < 2; ++n) acc[a][b][m][n] = (f32x4){0.f, 0.f, 0.f, 0.f};
    bf16x8 At[4][2], B0[2][2], B1[2][2];
    const char* cA = PG8_UA(cur); const char* cB = PG8_UB(cur);
    PG8_STAGE(PG8_SB(0, 0), cB, voffB); PG8_STAGE(PG8_SB(0, 1), cB + hsB, voffB); PG8_STAGE(PG8_SA(0, 0), cA, voffA); PG8_STAGE(PG8_SA(0, 1), cA + hsA, voffA);
    if (wr == 1) PG8_BAR;
    PG8_WAIT_V(2); PG8_BAR;
    PG8_STAGE(PG8_SB(1, 0), cB + kstep, voffB); PG8_STAGE(PG8_SA(1, 0), cA + kstep, voffA); PG8_STAGE(PG8_SB(1, 1), cB + hsB + kstep, voffB);
    PG8_WAIT_V(6); PG8_BAR;
    for (;;) {
        const bool has_next = S.next(ui + 1, nxt);
        const char* nA = has_next ? PG8_UA(nxt) : cA; const char* nB = has_next ? PG8_UB(nxt) : cB;
        for (int t = 0; t < nt; t += 2) {
            const bool last = (t == nt - 2);
            const char* a1 = cA + (size_t)(t + 1) * kstep;
            const char* a2 = last ? nA : cA + (size_t)(t + 2) * kstep; const char* b2 = last ? nB : cB + (size_t)(t + 2) * kstep;
            const char* a3 = a2 + kstep; const char* b3 = b2 + kstep;
            PG8_LDB(B0, 0, 0); PG8_LDB(B1, 0, 1); PG8_SCHED; PG8_LDA(At, 0, 0); PG8_STAGE(PG8_SA(1, 1), a1 + hsA, voffA);
            PG8_WAIT_V(8); PG8_WAIT_L(0); PG8_BAR; PG8_MMA(0, 0, At, B0); PG8_MMA(0, 1, At, B1); PG8_BAR; PG8_SCHED;
            PG8_LDA(At, 0, 1); PG8_STAGE(PG8_SB(0, 0), b2, voffB); PG8_STAGE(PG8_SB(0, 1), b2 + hsB, voffB); PG8_STAGE(PG8_SA(0, 0), a2, voffA);
            PG8_WAIT_V(8); PG8_WAIT_L(0); PG8_BAR; PG8_MMA(1, 0, At, B0); PG8_MMA(1, 1, At, B1); PG8_BAR; PG8_SCHED;
            PG8_LDB(B0, 1, 0); PG8_LDB(B1, 1, 1); PG8_SCHED; PG8_LDA(At, 1, 0); PG8_STAGE(PG8_SA(0, 1), a2 + hsA, voffA);
            PG8_WAIT_V(8); PG8_WAIT_L(0); PG8_BAR; PG8_MMA(0, 0, At, B0); PG8_MMA(0, 1, At, B1); PG8_BAR; PG8_SCHED;
            PG8_LDA(At, 1, 1); PG8_STAGE(PG8_SB(1, 0), b3, voffB); PG8_STAGE(PG8_SB(1, 1), b3 + hsB, voffB); PG8_STAGE(PG8_SA(1, 0), a3, voffA);
            PG8_WAIT_V(8); PG8_WAIT_L(0); PG8_BAR; PG8_MMA(1, 0, At, B0); PG8_MMA(1, 1, At, B1); PG8_BAR; PG8_SCHED;
        }
        if (wr == 0) PG8_BAR;
        E(acc, cur, wr, wc, fr, fq);
        if (!has_next) break;
#pragma unroll
        for (int a = 0; a < 2; ++a)
#pragma unroll
            for (int b = 0; b < 2; ++b)
#pragma unroll
                for (int m = 0; m < 4; ++m)
#pragma unroll
                    for (int n = 0; n < 2; ++n) acc[a][b][m][n] = (f32x4){0.f, 0.f, 0.f, 0.f};
        cur = nxt; cA = nA; cB = nB; ++ui;
        if (wr == 1) PG8_BAR;
    }
    PG8_WAIT_V(0);
    PG8_BAR;
#undef PG8_UA
#undef PG8_UB
#undef PG8_SA
#undef PG8_SB
#undef PG8_STAGE
#undef PG8_LDA
#undef PG8_LDB
#undef PG8_MMA
#undef PG8_WAIT_V
#undef PG8_WAIT_L
#undef PG8_BAR
#undef PG8_SCHED
}
}

#include <hip/hip_bf16.h>
#include <cmath>
namespace attn_body {
using bf16=__hip_bfloat16;
using bf16x8=__attribute__((ext_vector_type(8)))short;
using s16x4=__attribute__((ext_vector_type(4)))short;
using f32x16=__attribute__((ext_vector_type(16)))float;
using u32x4=__attribute__((ext_vector_type(4)))unsigned;
using f32x4v=__attribute__((ext_vector_type(4)))float;
constexpr int BATCH=4,NHEAD=32,SEQ=4096,D=64,DM=NHEAD*D;
constexpr int NW=8,QBLK=32,QB=QBLK*NW,KVBLK=64,NQB=SEQ/QB;
constexpr int ATTN_PITCH=DM, ATTN_UNIT_ROWS=QB;
__device__ __forceinline__ int crow(int r,int hi){return (r&3)+8*(r>>2)+4*hi;}
#define SBAR() __builtin_amdgcn_sched_barrier(0)
__device__ __forceinline__ void cmask(f32x16&p0,f32x16&p1,int jb,int qrel,int hi){
  const float NEG=-INFINITY; int kb=64*jb+4*hi;
  #pragma unroll
  for(int r=0;r<16;++r){int kv=kb+(r&3)+8*(r>>2); if(kv>qrel)p0[r]=NEG; if(kv+32>qrel)p1[r]=NEG;}
}

constexpr int NSLOT=3, SLOTB=8192;
constexpr int LDS_K=0, LDS_V=NSLOT*SLOTB, LDS_WS=2*NSLOT*SLOTB, LDS_OST=LDS_WS+NW*64*4, LDS_NB=LDS_OST+NW*4096, LDS_WT=LDS_NB+SEQ*4, LDS_BYTES=LDS_WT+64;
constexpr float C2=0.125f*1.4426950408889634f;
__device__ __forceinline__ void glds16(const void*gsrc,unsigned lds_dst){unsigned keep;
  asm volatile("s_mov_b32 %0, m0\n\ts_mov_b32 m0, %2\n\ts_nop 0\n\tglobal_load_lds_dwordx4 %1, off\n\ts_mov_b32 m0, %0":"=&s"(keep):"v"(gsrc),"s"(lds_dst):"memory");}
__device__ __forceinline__ float max3f(float a,float b,float c){float r;asm("v_max3_f32 %0, %1, %2, %3":"=v"(r):"v"(a),"v"(b),"v"(c));return r;}
__device__ __forceinline__ float max2f(float a,float b){float r;asm("v_max_f32_e32 %0, %1, %2":"=v"(r):"v"(a),"v"(b));return r;}
__device__ __forceinline__ float fadd_s(float a,float b){float r;asm("v_add_f32_e32 %0, %1, %2":"=v"(r):"v"(a),"v"(b));return r;}
__device__ __forceinline__ float fsub_s(float a,float b){float r;asm("v_sub_f32_e32 %0, %1, %2":"=v"(r):"v"(a),"v"(b));return r;}
typedef float f32x2_t __attribute__((ext_vector_type(2))); typedef __bf16 bf16x2_t __attribute__((ext_vector_type(2)));
__device__ __forceinline__ unsigned cvtpk_s(float lo,float hi){f32x2_t v={lo,hi};bf16x2_t b=__builtin_convertvector(v,bf16x2_t);return __builtin_bit_cast(unsigned,b);}
#define WAIT_BAR(N) asm volatile("s_waitcnt vmcnt(" #N ") lgkmcnt(0)\n\ts_barrier":::"memory")

__device__ __forceinline__ void qkt(f32x16&p0,f32x16&p1,const char*Kslot,const bf16x8*qr,int r32,int hi){
  const char*kb=Kslot+hi*1024+r32*16;
  #pragma unroll
  for(int d0=0;d0<4;++d0){
    const bf16x8 b0=*reinterpret_cast<const bf16x8*>(kb+d0*2048);
    const bf16x8 b1=*reinterpret_cast<const bf16x8*>(kb+d0*2048+512);
    p0=__builtin_amdgcn_mfma_f32_32x32x16_bf16(b0,qr[d0],p0,0,0,0);p1=__builtin_amdgcn_mfma_f32_32x32x16_bf16(b1,qr[d0],p1,0,0,0);}
}
typedef __attribute__((address_space(3))) const char* lds_cptr;
typedef short v4i16_t __attribute__((ext_vector_type(4)));
__device__ __forceinline__ void kload8(bf16x8*kf,lds_cptr kp){
  kf[0]=*(const __attribute__((address_space(3))) bf16x8*)(kp);      kf[1]=*(const __attribute__((address_space(3))) bf16x8*)(kp+512);
  kf[2]=*(const __attribute__((address_space(3))) bf16x8*)(kp+2048); kf[3]=*(const __attribute__((address_space(3))) bf16x8*)(kp+2560);
  kf[4]=*(const __attribute__((address_space(3))) bf16x8*)(kp+4096); kf[5]=*(const __attribute__((address_space(3))) bf16x8*)(kp+4608);
  kf[6]=*(const __attribute__((address_space(3))) bf16x8*)(kp+6144); kf[7]=*(const __attribute__((address_space(3))) bf16x8*)(kp+6656);
}
__device__ __forceinline__ void kload2(bf16x8*kf,lds_cptr kp,int j){ kf[2*j]=*(const __attribute__((address_space(3))) bf16x8*)(kp+j*2048); kf[2*j+1]=*(const __attribute__((address_space(3))) bf16x8*)(kp+j*2048+512); }
__device__ __forceinline__ s16x4 vtr(lds_cptr p){ return __builtin_bit_cast(s16x4,__builtin_amdgcn_ds_read_tr16_b64_v4i16((__attribute__((address_space(3))) v4i16_t*)p)); }
__device__ __forceinline__ float rowmax(const f32x16&p0,const f32x16&p1){
  float a=max3f(p0[0],p0[1],p1[0]),b=max3f(p0[2],p0[3],p1[1]);a=max3f(a,p1[2],p1[3]);
  #pragma unroll
  for(int r=4;r<16;r+=4){a=max3f(a,p0[r],p0[r+1]);b=max3f(b,p0[r+2],p0[r+3]);a=max3f(a,p1[r],p1[r+1]);b=max3f(b,p1[r+2],p1[r+3]);}
  const float m=max2f(a,b);
  auto rr=__builtin_amdgcn_permlane32_swap(__float_as_uint(m),__float_as_uint(m),false,false);
  return max2f(__uint_as_float(rr[0]),__uint_as_float(rr[1]));
}
__device__ __forceinline__ void pv(f32x16*o,int vb,bf16x8 pa0,bf16x8 pa1,bf16x8 pa2,bf16x8 pa3){
  #pragma unroll
  for(int d0=0;d0<2;++d0){s16x4 lo[4],hi[4];
    #pragma unroll
    for(int ks=0;ks<4;++ks){
      asm volatile("ds_read_b64_tr_b16 %0,%1 offset:%c2":"=&v"(lo[ks]):"v"(vb),"i"(d0*4096+ks*1024):"memory");
      asm volatile("ds_read_b64_tr_b16 %0,%1 offset:%c2":"=&v"(hi[ks]):"v"(vb),"i"(d0*4096+ks*1024+512):"memory");}
    asm volatile("s_waitcnt lgkmcnt(0)":::"memory");SBAR();
    #define PK(k) (bf16x8){lo[k][0],lo[k][1],lo[k][2],lo[k][3],hi[k][0],hi[k][1],hi[k][2],hi[k][3]}
    o[d0]=__builtin_amdgcn_mfma_f32_32x32x16_bf16(pa0,PK(0),o[d0],0,0,0);
    o[d0]=__builtin_amdgcn_mfma_f32_32x32x16_bf16(pa1,PK(1),o[d0],0,0,0);
    o[d0]=__builtin_amdgcn_mfma_f32_32x32x16_bf16(pa2,PK(2),o[d0],0,0,0);
    o[d0]=__builtin_amdgcn_mfma_f32_32x32x16_bf16(pa3,PK(3),o[d0],0,0,0);
    #undef PK
  }
}

#ifndef ATTN_STORE16
#define ATTN_STORE16(p,v) (*(u32x4*)(p)=(v))
#endif
template<int THRL> __device__ __forceinline__ void attn_unit(int b,int h,int qb,const bf16*Q,const bf16*__restrict__ K,const bf16*__restrict__ V,bf16*O,const bf16*__restrict__ SG,char*shm,const int tid){
  const int lane=tid&63,r32=lane&31,hi=lane>>5; const int wid=__builtin_amdgcn_readfirstlane(tid>>6);
  const long rowbase=(long)b*SEQ; const int q0=qb*QB;
  const bf16*Qw=Q+(rowbase+q0+wid*QBLK)*DM+h*D;
  const bf16*Kh=K+rowbase*DM+h*D,*Vh=V+rowbase*DM+h*D;
  const lds_cptr shm3=(lds_cptr)shm;
  const unsigned lds0=(unsigned)(uintptr_t)shm;
  float*wsf=(float*)(shm+LDS_WS)+wid*64;
  const bf16*ksrc=Kh+(long)lane*DM+wid*8;
  const bf16*vsrc=Vh+(long)(16*(wid&3)+(lane>>2))*DM+(wid>>2)*32+(lane&3)*8;
  const unsigned kdst=lds0+LDS_K+wid*1024, vdst=lds0+LDS_V+wid*1024;
  #define DMA_K(t,slot) glds16(ksrc+(long)(t)*KVBLK*DM,(unsigned)__builtin_amdgcn_readfirstlane(kdst+(slot)))
  #define DMA_V(t,slot) glds16(vsrc+(long)(t)*KVBLK*DM,(unsigned)__builtin_amdgcn_readfirstlane(vdst+(slot)))
  const int vb0=(int)(lds0+LDS_V)+((lane>>4)&1)*32+(lane&3)*8+(4*hi+((lane&15)>>2))*64;
  const char*Kbase=shm+LDS_K; bf16x8 kf[8];
  const lds_cptr kp0=shm3+LDS_K+hi*1024+r32*16; const lds_cptr vp0=shm3+LDS_V+((lane>>4)&1)*32+(lane&3)*8+(4*hi+((lane&15)>>2))*64;
  const int NT=(q0+QB)/KVBLK;
  DMA_K(0,0);DMA_V(0,0);DMA_K(1,SLOTB);
  bf16x8 qr[4];
  #pragma unroll
  for(int d0=0;d0<4;++d0)qr[d0]=*reinterpret_cast<const bf16x8*>(&Qw[(long)r32*DM+d0*16+hi*8]);
  float mhat=0.f,l_reg=0.f;f32x16 o[2];o[0]=f32x16{};o[1]=f32x16{};
  const int qrel=wid*QBLK+r32;
  typedef __attribute__((address_space(3))) const f32x4v* nb_ptr; const nb_ptr nbp0=(nb_ptr)(shm3+LDS_NB)+hi;
  const float nbq=((const __attribute__((address_space(3))) float*)(shm3+LDS_NB))[q0+qrel]; float negs=-nbq;
  #define CINIT(C0,C1,t) do{ const nb_ptr bp_=nbp0+(t)*16; _Pragma("unroll") for(int j_=0;j_<4;++j_){ const f32x4v a_=bp_[2*j_], b_=bp_[8+2*j_]; \
      C0[4*j_]=a_[0]+negs; C0[4*j_+1]=a_[1]+negs; C0[4*j_+2]=a_[2]+negs; C0[4*j_+3]=a_[3]+negs; \
      C1[4*j_]=b_[0]+negs; C1[4*j_+1]=b_[1]+negs; C1[4*j_+2]=b_[2]+negs; C1[4*j_+3]=b_[3]+negs; } }while(0)
  #define CMASK(P0,P1,t) do{int jb_=(t)-(NT-4); if(jb_>=0)cmask(P0,P1,jb_,qrel,hi);}while(0)
  bool resc=false;
  #define START(P0,P1) do{ const float rm=rowmax(P0,P1); resc=false; \
    if(__any(rm>(float)THRL)){ const float dl=__builtin_fmaxf(rm,0.f); mhat+=dl; \
      _Pragma("unroll") for(int r=0;r<16;++r){P0[r]-=dl;P1[r]-=dl;} negs=-nbq-mhat; } \
    _Pragma("unroll") for(int r=0;r<16;++r)P0[r]=__builtin_amdgcn_exp2f(P0[r]); }while(0)
  #define RESC() do{ if(resc){ asm volatile("s_waitcnt lgkmcnt(0)":::"memory"); \
      _Pragma("unroll") for(int d_=0;d_<2;++d_) _Pragma("unroll") for(int r=0;r<16;++r)o[d_][r]*=wsf[crow(r,hi)]; } }while(0)
  f32x16 pA0,pA1,pB0,pB1;
  int sl_prev=0,sl_cur=0,sl_next=SLOTB;
  #define ROT() do{sl_prev=sl_cur;sl_cur=sl_next;sl_next=(sl_next==(NSLOT-1)*SLOTB)?0:sl_next+SLOTB;}while(0)
  DMA_K(2,2*SLOTB);
  WAIT_BAR(3);
  CINIT(pA0,pA1,0); qkt(pA0,pA1,Kbase,qr,r32,hi);asm volatile("s_nop 15\n\ts_nop 7":"+v"(pA0),"+v"(pA1));CMASK(pA0,pA1,0);
  START(pA0,pA1);
  _Pragma("unroll") for(int r=0;r<16;++r)pA1[r]=__builtin_amdgcn_exp2f(pA1[r]);
  WAIT_BAR(0);
  DMA_K(3,0);DMA_V(1,SLOTB);
  ROT();
  kload8(kf,kp0+sl_cur);
  WAIT_BAR(2);
  s16x4 vlo[8],vhi[8]; u32x4 pw0,pw1,pw2,pw3;
  #define PKW(P,B) cvtpk_s(P[B],P[B+1])
  #define PAF(k) __builtin_bit_cast(bf16x8,pw##k)
  #define VFR(i) (bf16x8){vlo[i][0],vlo[i][1],vlo[i][2],vlo[i][3],vhi[i][0],vhi[i][1],vhi[i][2],vhi[i][3]}
  #define PIN(x) asm volatile("":"+v"(x))
  #define MX3(a,b,c) __builtin_fmaxf(__builtin_fmaxf((a),(b)),(c))
  #define GAPA(MF,A0,A1,A2,A3,W0,W1,PW) do{ MF; sacc+=A0; sacc+=A1; sacc+=A2; sacc+=A3; PIN(sacc); W0; W1; PIN(PW); SBAR(); }while(0)
  #define EX(v) __builtin_amdgcn_exp2f(v)
  #define GAPB(MF,X,B) do{ MF; X[B]=EX(X[B]); X[B+1]=EX(X[B+1]); X[B+2]=EX(X[B+2]); X[B+3]=EX(X[B+3]); PIN(X); SBAR(); }while(0)
  #define VRD(i) do{ vlo[i]=vtr(vp_+(((i)>>2)*4096+((i)&3)*1024)); vhi[i]=vtr(vp_+(((i)>>2)*4096+((i)&3)*1024+512)); }while(0)
  #define KRD(G,j) do{ if(G){ kload2(kf,kp0+sl_next,j); SBAR(); } }while(0)
  #define STEP(C0,C1,P0,P1,t,GK,GV,GL) do{ SBAR(); CINIT(C0,C1,t); SBAR(); \
    const lds_cptr vp_=vp0+sl_prev; \
    VRD(0); SBAR(); float sacc=(P0[0]+P0[1]); \
    GAPA(C0=__builtin_amdgcn_mfma_f32_32x32x16_bf16(kf[0],qr[0],C0,0,0,0), P0[2],P0[3],P0[4],P0[5],     pw0[0]=PKW(P0,0), pw0[1]=PKW(P0,2), pw0); \
    VRD(4); SBAR(); GAPA(C1=__builtin_amdgcn_mfma_f32_32x32x16_bf16(kf[1],qr[0],C1,0,0,0), P0[6],P0[7],P0[8],P0[9],     pw0[2]=PKW(P0,4), pw0[3]=PKW(P0,6), pw0); \
    VRD(1); SBAR(); GAPA(C0=__builtin_amdgcn_mfma_f32_32x32x16_bf16(kf[2],qr[1],C0,0,0,0),   P0[10],P0[11],P0[12],P0[13], pw1[0]=PKW(P0,8), pw1[1]=PKW(P0,10), pw1); \
    VRD(5); SBAR(); GAPA(C1=__builtin_amdgcn_mfma_f32_32x32x16_bf16(kf[3],qr[1],C1,0,0,0),   P0[14],P0[15],P1[0],P1[1],   pw1[2]=PKW(P0,12),pw1[3]=PKW(P0,14), pw1); \
    VRD(2); SBAR(); GAPA(C0=__builtin_amdgcn_mfma_f32_32x32x16_bf16(kf[4],qr[2],C0,0,0,0),   P1[2],P1[3],P1[4],P1[5],     pw2[0]=PKW(P1,0), pw2[1]=PKW(P1,2), pw2); \
    VRD(6); SBAR(); GAPA(C1=__builtin_amdgcn_mfma_f32_32x32x16_bf16(kf[5],qr[2],C1,0,0,0),   P1[6],P1[7],P1[8],P1[9],     pw2[2]=PKW(P1,4), pw2[3]=PKW(P1,6), pw2); \
    VRD(3); SBAR(); GAPA(C0=__builtin_amdgcn_mfma_f32_32x32x16_bf16(kf[6],qr[3],C0,0,0,0),   P1[10],P1[11],P1[12],P1[13], pw3[0]=PKW(P1,8), pw3[1]=PKW(P1,10), pw3); \
    VRD(7); SBAR(); GAPA(C1=__builtin_amdgcn_mfma_f32_32x32x16_bf16(kf[7],qr[3],C1,0,0,0),   P1[14],P1[15],0.f,0.f,       pw3[2]=PKW(P1,12),pw3[3]=PKW(P1,14), pw3); \
    l_reg+=sacc; \
    if(GK){DMA_K((t)+3,sl_cur);} if(GV){DMA_V((t)+1,sl_next);} \
    CMASK(C0,C1,t); \
    { float a=MX3(C0[0],C0[1],C1[0]),b=MX3(C0[2],C0[3],C1[1]); a=MX3(a,C1[2],C1[3]); \
      _Pragma("unroll") for(int r=4;r<16;r+=4){a=MX3(a,C0[r],C0[r+1]);b=MX3(b,C0[r+2],C0[r+3]);a=MX3(a,C1[r],C1[r+1]);b=MX3(b,C1[r+2],C1[r+3]);} \
      float rm=__builtin_fmaxf(a,b); { auto rr=__builtin_amdgcn_permlane32_swap(__float_as_uint(rm),__float_as_uint(rm),false,false); rm=__builtin_fmaxf(__uint_as_float(rr[0]),__uint_as_float(rr[1])); } \
      resc=false; \
      if(__builtin_expect(__any(rm>(float)THRL),0)){ const float dl=__builtin_fmaxf(rm,0.f); mhat+=dl; \
        _Pragma("unroll") for(int r=0;r<16;++r){C0[r]-=dl;C1[r]-=dl;} \
        negs=-nbq-mhat; \
        const float f=__builtin_amdgcn_exp2f(-dl); l_reg*=f; if(hi==0)wsf[r32]=f; resc=true; } } \
    SBAR(); \
    GAPB(o[0]=__builtin_amdgcn_mfma_f32_32x32x16_bf16(PAF(0),VFR(0),o[0],0,0,0), C0,0); \
    GAPB(o[1]=__builtin_amdgcn_mfma_f32_32x32x16_bf16(PAF(0),VFR(4),o[1],0,0,0), C0,4); \
    KRD(GL,0); GAPB(o[0]=__builtin_amdgcn_mfma_f32_32x32x16_bf16(PAF(1),VFR(1),o[0],0,0,0), C0,8); \
    KRD(GL,1); GAPB(o[1]=__builtin_amdgcn_mfma_f32_32x32x16_bf16(PAF(1),VFR(5),o[1],0,0,0), C0,12); \
    KRD(GL,2); GAPB(o[0]=__builtin_amdgcn_mfma_f32_32x32x16_bf16(PAF(2),VFR(2),o[0],0,0,0), C1,0); \
    KRD(GL,3); GAPB(o[1]=__builtin_amdgcn_mfma_f32_32x32x16_bf16(PAF(2),VFR(6),o[1],0,0,0), C1,4); \
    GAPB(o[0]=__builtin_amdgcn_mfma_f32_32x32x16_bf16(PAF(3),VFR(3),o[0],0,0,0), C1,8); \
    GAPB(o[1]=__builtin_amdgcn_mfma_f32_32x32x16_bf16(PAF(3),VFR(7),o[1],0,0,0), C1,12); \
    }while(0)
  int t=1;
  #undef CMASK
  #define CMASK(P0,P1,t) do{}while(0)
  for(;t+5<NT;t+=2){
    STEP(pB0,pB1,pA0,pA1,t,true,true,true);     WAIT_BAR(2); RESC(); ROT();
    STEP(pA0,pA1,pB0,pB1,t+1,true,true,true);   WAIT_BAR(2); RESC(); ROT();
  }
  #undef CMASK
  #define CMASK(P0,P1,t) do{int jb_=(t)-(NT-4); if(jb_>=0)cmask(P0,P1,jb_,qrel,hi);}while(0)
  #define ENDW(tt) do{ if((tt)+3<NT){WAIT_BAR(2);} else if((tt)+2<NT){WAIT_BAR(1);} else {WAIT_BAR(0);} }while(0)
  for(;t+1<NT;t+=2){
    STEP(pB0,pB1,pA0,pA1,t,(t+3<NT),(t+1<NT),(t+1<NT));       ENDW(t);   RESC(); ROT();
    STEP(pA0,pA1,pB0,pB1,t+1,(t+4<NT),(t+2<NT),(t+2<NT));     ENDW(t+1); RESC(); ROT();
  }
  STEP(pB0,pB1,pA0,pA1,NT-1,false,false,false); RESC();
  { float sacc=pB0[0]+pB0[1]; _Pragma("unroll") for(int r=2;r<16;++r)sacc+=pB0[r]; _Pragma("unroll") for(int r=0;r<16;++r)sacc+=pB1[r]; l_reg+=sacc;
    pw0=(u32x4){PKW(pB0,0),PKW(pB0,2),PKW(pB0,4),PKW(pB0,6)};pw1=(u32x4){PKW(pB0,8),PKW(pB0,10),PKW(pB0,12),PKW(pB0,14)};pw2=(u32x4){PKW(pB1,0),PKW(pB1,2),PKW(pB1,4),PKW(pB1,6)};pw3=(u32x4){PKW(pB1,8),PKW(pB1,10),PKW(pB1,12),PKW(pB1,14)};
    SBAR(); pv(o,vb0+sl_cur,PAF(0),PAF(1),PAF(2),PAF(3)); }
  #undef PKW
  #undef PAF
  #undef VFR
  #undef PIN
  #undef MX3
  #undef GAPA
  #undef GAPB
  #undef EX
  #undef VRD
  #undef KRD
  #undef STEP
  #undef ENDW
  {auto rr=__builtin_amdgcn_permlane32_swap(__float_as_uint(l_reg),__float_as_uint(l_reg),false,false);l_reg=__uint_as_float(rr[0])+__uint_as_float(rr[1]);}
  if(hi==0)wsf[32+r32]=l_reg;asm volatile("s_waitcnt lgkmcnt(0)":::"memory");
  float rli[16];
  #pragma unroll
  for(int r=0;r<16;++r)rli[r]=__builtin_amdgcn_rcpf(wsf[32+crow(r,hi)]);
  bf16*Ow=O+(rowbase+q0+wid*QBLK)*DM+h*D; const bf16*Gw=SG+(rowbase+q0+wid*QBLK)*DM+h*D;
  { bf16*stg=(bf16*)(shm+LDS_OST)+wid*2048;
    #pragma unroll
    for(int r=0;r<16;++r){const int orow=crow(r,hi);
      #pragma unroll
      for(int d0=0;d0<2;++d0)stg[orow*64+d0*32+r32]=__float2bfloat16(o[d0][r]*rli[r]);}
    asm volatile("s_waitcnt lgkmcnt(0)":::"memory");
    #pragma unroll
    for(int i=0;i<4;++i){const int row=i*8+(lane>>3),ch=lane&7; u32x4 v=*(const u32x4*)(stg+row*64+ch*8); const u32x4 gv=*(const u32x4*)(Gw+(long)row*DM+ch*8);
      #pragma unroll
      for(int e=0;e<4;++e){ const float a0=__uint_as_float(v[e]<<16),a1=__uint_as_float(v[e]&0xffff0000u),g0=__uint_as_float(gv[e]<<16),g1=__uint_as_float(gv[e]&0xffff0000u); v[e]=cvtpk_s(a0*g0,a1*g1); }
      ATTN_STORE16(Ow+(long)row*DM+ch*8,v);} }
  asm volatile("s_waitcnt lgkmcnt(0)\n\ts_barrier":::"memory");
  #undef DMA_K
  #undef DMA_V
  #undef CMASK
  #undef CINIT
  #undef START
  #undef RESC
  #undef ROT
}
constexpr int ATTN_LDS_BYTES=LDS_BYTES;
struct AttnTensors { const bf16* Q; const bf16* K; const bf16* V; bf16* O; const bf16* SG; const float* logf; };
__device__ __forceinline__ void fox_scan(char*shm,const float*__restrict__ logf,int bh,const int tid){
  const int lane=tid&63,wid=tid>>6; const int b=bh/NHEAD,h=bh%NHEAD;
  const float*src=logf+((long)b*SEQ+(long)tid*8)*NHEAD+h; float v[8];
  #pragma unroll
  for(int i=0;i<8;++i)v[i]=src[i*NHEAD];
  #pragma unroll
  for(int i=1;i<8;++i)v[i]+=v[i-1];
  const float tot=v[7]; float sc=tot;
  #pragma unroll
  for(int off=1;off<64;off<<=1){const float o_=__shfl_up(sc,off); if(lane>=off)sc+=o_;}
  float*wt=(float*)(shm+LDS_WT); float*nb=(float*)(shm+LDS_NB);
  __syncthreads();
  if(lane==63)wt[wid]=sc;
  __syncthreads();
  float woff=0.f;
  #pragma unroll
  for(int w=0;w<8;++w)woff+=(w<wid)?wt[w]:0.f;
  const float excl=woff+sc-tot;
  #pragma unroll
  for(int i=0;i<8;++i)nb[tid*8+i]=-(excl+v[i])*1.4426950408889634f;
  __syncthreads();
}
template<int THRL=8> __device__ __forceinline__ void attn_phase(char*lds,const AttnTensors&T,int vcu,int G,const int tid0){
  int cur_bh=-1;
  for(int e=vcu;e<BATCH*NHEAD*2;e+=G){
    const int bh=e>>1,s=e&1;
    if(bh!=cur_bh){ fox_scan(lds,T.logf,bh,tid0); cur_bh=bh; }
    for(int i=0;i<8;++i){ const int base=2*(i>>1)+s; const int qb=(i&1)?(15-base):base; int tid=tid0; asm volatile("":"+v"(tid));
      attn_unit<THRL>(bh/NHEAD,bh%NHEAD,qb,T.Q,T.K,T.V,T.O,T.SG,lds,tid); }
  }
}
#undef SBAR
#undef WAIT_BAR
}

constexpr size_t MiB = 1u << 20;
constexpr size_t WS_SSQ = 1 * MiB;
constexpr size_t WS_LOGF = 2 * MiB;
constexpr size_t WS_WPOOL = 4 * MiB, WPOOL_L = 2 * MiB;
constexpr size_t WS_WOUT = 8 * MiB, WOUT_L = 8 * MiB;
constexpr size_t WS_WIN = 24 * MiB, WIN_L = 33 * MiB;
constexpr size_t WS_WD = 90 * MiB, WD_L = 22 * MiB;
constexpr size_t WS_WGU = 178 * MiB, WGU_L = 44 * MiB;
constexpr size_t WS_HB = 354 * MiB;
constexpr size_t WS_Q = 418 * MiB, ACT_MD = 64 * MiB;
constexpr size_t WS_ACT = 674 * MiB;
constexpr size_t WS_END = 850 * MiB;
static_assert((size_t)NIN_PAD * DM * 2 == WIN_L && (size_t)DM * FF * 2 == WD_L && (size_t)NGU * DM * 2 == WGU_L && (size_t)M * DM * 2 == ACT_MD && (size_t)M * FF * 2 == 176 * MiB, "ws map");

constexpr int LDS_BYTES = 147456;
constexpr int NWAVES = 8;
static_assert(attn_body::LDS_BYTES <= 131072, "attention LDS");

#define LAS __attribute__((address_space(3)))
typedef unsigned short bf16;
typedef unsigned v4u __attribute__((ext_vector_type(4)));
typedef unsigned v2u __attribute__((ext_vector_type(2)));
typedef float f32x4 __attribute__((ext_vector_type(4)));
#define LDS_WAIT() asm volatile("s_waitcnt lgkmcnt(0)" ::: "memory")
__device__ __forceinline__ unsigned pk2(float lo, float hi) { return pg8::cvt_pk_bf16(lo, hi); }
__device__ __forceinline__ float wave_sum(float v) {
#pragma unroll
    for (int o = 1; o < 64; o <<= 1) v += __shfl_xor(v, o);
    return v;
}

__device__ __forceinline__ int map_row_gu(int n) { const int j = n < FF ? n : n - FF; return (j >> 7) * 256 + (n < FF ? 0 : 128) + (j & 127); }
__device__ __forceinline__ int map_row_in(int n) { if (n >= 4 * DM) return n; const int t = n >> 11, r = n & 2047, head = r >> 6, d = r & 63; return (t * 8 + (head >> 2)) * 256 + (d >> 5) * 128 + (head & 3) * 32 + (d & 31); }
template <int MAP> __device__ __forceinline__ void tr_item(const float* __restrict__ W, int K, int N, bf16* __restrict__ WT, const float* __restrict__ gain, LAS float* scr, int kb, int nb, int lane) {
    const int k0 = kb * 64, n0 = nb * 64, n4 = lane & 15, kr = lane >> 4;
    const bool nok = (n0 + 4 * n4) < N;
#pragma unroll 8
    for (int i = 0; i < 16; ++i) { const int kk = 4 * i + kr; f32x4 v = (f32x4){0.f, 0.f, 0.f, 0.f};
        if (nok) v = *(const f32x4*)(W + (size_t)(k0 + kk) * N + n0 + 4 * n4);
        if (gain) v = v * gain[k0 + kk];
        LAS float* s = scr + kk * 65 + 4 * n4; s[0] = v[0]; s[1] = v[1]; s[2] = v[2]; s[3] = v[3]; }
    LDS_WAIT();
    const int c = lane & 7;
#pragma unroll
    for (int j = 0; j < 8; ++j) { const int n = (lane >> 3) + 8 * j;
        if (n0 + n < N) { const LAS float* s = scr + (8 * c) * 65 + n;
            v4u o; o.x = pk2(s[0 * 65], s[1 * 65]); o.y = pk2(s[2 * 65], s[3 * 65]); o.z = pk2(s[4 * 65], s[5 * 65]); o.w = pk2(s[6 * 65], s[7 * 65]);
            const int nn = n0 + n; const int row = MAP == 1 ? map_row_gu(nn) : (MAP == 2 ? map_row_in(nn) : nn);
            *(v4u*)(WT + (size_t)row * K + k0 + 8 * c) = o; } }
    LDS_WAIT();
}

struct Args { const float* in[13]; float* out; unsigned char* ws; int ph_lo, ph_hi; };

constexpr int NPHASE = 20;
__device__ __forceinline__ void phase_info(int ph, int& type, int& layer) {
    if (ph == 0) { type = 0; layer = 0; return; }
    if (ph == NPHASE - 1) { type = 8; layer = 0; return; }
    int p = ph - 1; int l = 0;
    if (p >= 4) { p -= 4; l = 1; if (p >= 5) { p -= 5; l = 2; if (p >= 4) { p -= 4; l = 3; } } }
    layer = l;
    if ((l & 1) == 0) type = (p == 0) ? 1 : (p == 1) ? 2 : (p == 2) ? 3 : 4;
    else type = (p == 0) ? 5 : (p == 1) ? 6 : (p == 2) ? 7 : (p == 3) ? 3 : 4;
}

__global__ void __launch_bounds__(NWAVES * 64, 2) fwd_kernel(Args args) {
    extern __shared__ __attribute__((aligned(16))) unsigned char lds[];
    cg::grid_group grid = cg::this_grid();
    unsigned char* ws = args.ws;
    const float* x = args.in[0]; const float* attn_g = args.in[1]; const float* ffn_g = args.in[2]; const float* final_g = args.in[3];
    const float* pool_w = args.in[4]; const float* pool_scale = args.in[5]; const float* w_in = args.in[6]; const float* b_f = args.in[7];
    const float* qn_g = args.in[8]; const float* kn_g = args.in[9]; const float* w_out = args.in[10]; const float* w_gu = args.in[11]; const float* w_dn = args.in[12];
    float* H = args.out;
    float* SSQ = (float*)(ws + WS_SSQ); float* LOGF = (float*)(ws + WS_LOGF);
    bf16* HB = (bf16*)(ws + WS_HB); bf16* QB = (bf16*)(ws + WS_Q); bf16* ACT = (bf16*)(ws + WS_ACT);
    LAS unsigned char* ldsl = (LAS unsigned char*)lds;

    for (int ph = args.ph_lo; ph < args.ph_hi; ++ph) {
        int type, layer; phase_info(ph, type, layer);
        int tid = threadIdx.x; asm volatile("" : "+v"(tid)); int bx = blockIdx.x; asm volatile("" : "+s"(bx)); int G = gridDim.x; asm volatile("" : "+s"(G));
        const int lane = tid & 63, wave = __builtin_amdgcn_readfirstlane(tid >> 6);
        const int vcu = (G % 8 == 0) ? (bx % 8) * (G / 8) + bx / 8 : bx;
        const int j2 = layer >> 1;
        if (type == 0) {
            LAS float* scr = (LAS float*)(ldsl + wave * 16640);
            const int gw = vcu * NWAVES + wave, NGW = G * NWAVES;
            constexpr int I_GU = 32 * 176, I_DN = 88 * 32, I_IN = 32 * 129, I_OUT = 32 * 32, I_PL = 8 * 8;
            constexpr int T_GU = 4 * I_GU, T_DN = 4 * I_DN, T_IN = 2 * I_IN, T_OUT = 2 * I_OUT, T_PL = 8 * I_PL;
            for (int it = gw; it < T_GU + T_DN + T_IN + T_OUT + T_PL; it += NGW) {
                int r = it;
                if (r < T_GU) { const int l = r / I_GU; r %= I_GU; tr_item<1>(w_gu + (size_t)l * DM * NGU, DM, NGU, (bf16*)(ws + WS_WGU + l * WGU_L), ffn_g + l * DM, scr, r / 176, r % 176, lane); continue; } r -= T_GU;
                if (r < T_DN) { const int l = r / I_DN; r %= I_DN; tr_item<0>(w_dn + (size_t)l * FF * DM, FF, DM, (bf16*)(ws + WS_WD + l * WD_L), nullptr, scr, r / 32, r % 32, lane); continue; } r -= T_DN;
                if (r < T_IN) { const int l = r / I_IN; r %= I_IN; tr_item<2>(w_in + (size_t)l * DM * NIN, DM, NIN, (bf16*)(ws + WS_WIN + l * WIN_L), attn_g + (2 * l + 1) * DM, scr, r / 129, r % 129, lane); continue; } r -= T_IN;
                if (r < T_OUT) { const int l = r / I_OUT; r %= I_OUT; tr_item<0>(w_out + (size_t)l * DM * DM, DM, DM, (bf16*)(ws + WS_WOUT + l * WOUT_L), nullptr, scr, r / 32, r % 32, lane); continue; } r -= T_OUT;
                { const int lg = r / I_PL; r %= I_PL; tr_item<0>(pool_w + (size_t)lg * PG * PG, PG, PG, (bf16*)(ws + WS_WPOOL) + (size_t)lg * PG * PG, nullptr, scr, r / 8, r % 8, lane); }
            }
            for (int m = gw; m < M; m += NGW) {
                const f32x4* xr = (const f32x4*)(x + (size_t)m * DM) + lane; float s = 0.f; f32x4 v[8];
#pragma unroll
                for (int j = 0; j < 8; ++j) { v[j] = xr[64 * j]; const f32x4 q = v[j] * v[j]; s += (q[0] + q[1]) + (q[2] + q[3]); }
                s = wave_sum(s);
                v2u* o8 = (v2u*)(HB + (size_t)m * DM) + lane;
#pragma unroll
                for (int j = 0; j < 8; ++j) { v2u w; w.x = pk2(v[j][0], v[j][1]); w.y = pk2(v[j][2], v[j][3]); o8[64 * j] = w; }
                if (lane == 0) SSQ[m] = s;
            }
            for (int i = bx * (NWAVES * 64) + tid; i < 8 * M; i += G * NWAVES * 64) SSQ[M + i] = 0.f;
        } else if (type == 1) {
            const float* hs = (layer == 0) ? x : H; const float* ssq = SSQ + (size_t)(2 * layer) * M;
            const int c4 = tid * 4, win = 2 << (tid >> 7);
            const f32x4 g4 = *(const f32x4*)(attn_g + layer * DM + c4);
            for (int ch = vcu; ch < M / 64; ch += G) {
                const int t0 = ch * 64, tp0 = t0 & (SEQ - 1);
                f32x4 s = (f32x4){0.f, 0.f, 0.f, 0.f};
                for (int j = 1; j < win; ++j) if (tp0 - j >= 0) { const int r = t0 - j; s += *(const f32x4*)(hs + (size_t)r * DM + c4) * (pg8::rstd_row(ssq, r)); }
                s = s * g4;
#pragma unroll 8
                for (int i = 0; i < 64; ++i) { const int r = t0 + i;
                    const f32x4 v = *(const f32x4*)(hs + (size_t)r * DM + c4) * (pg8::rstd_row(ssq, r)) * g4;
                    s += v; const int cnt = min(tp0 + i + 1, win); const f32x4 f = s * (1.0f / (float)cnt) - v;
                    v2u w; w.x = pk2(f[0], f[1]); w.y = pk2(f[2], f[3]); *(v2u*)(QB + (size_t)r * DM + c4) = w;
                    const int ro = r - (win - 1);
                    if (tp0 + i - (win - 1) >= 0) s -= *(const f32x4*)(hs + (size_t)ro * DM + c4) * (pg8::rstd_row(ssq, ro)) * g4; }
            }
        } else if (type == 2) {
            pg8::Gemm g{QB, (const bf16*)(ws + WS_WPOOL + j2 * WPOOL_L), M, DM, PG, DM, 2}; pg8::StaticOrder S; S.init(M, DM, G, bx);
            pg8::EpiResid E{(layer == 0) ? x : H, H, HB, SSQ + (size_t)(2 * layer + 1) * M, pool_scale + j2 * DM};
            pg8::gemm_phase<pg8::EpiResid>(ldsl, g, S, E, tid);
        } else if (type == 3) {
            pg8::Gemm g{HB, (const bf16*)(ws + WS_WGU + layer * WGU_L), M, NGU, DM, DM, 1 << 20}; pg8::StaticOrder S; S.init(M, NGU, G, bx);
            pg8::EpiSwiglu E{ACT, SSQ + (size_t)(2 * layer + 1) * M};
            pg8::gemm_phase<pg8::EpiSwiglu>(ldsl, g, S, E, tid);
        } else if (type == 4) {
            pg8::Gemm g{ACT, (const bf16*)(ws + WS_WD + layer * WD_L), M, DM, FF, FF, 1 << 20}; pg8::StaticOrder S; S.init(M, DM, G, bx);
            pg8::EpiResid E{H, H, (layer < 3) ? HB : nullptr, SSQ + (size_t)(2 * layer + 2) * M, nullptr};
            pg8::gemm_phase<pg8::EpiResid>(ldsl, g, S, E, tid);
        } else if (type == 5) {
            pg8::Gemm g{HB, (const bf16*)(ws + WS_WIN + j2 * WIN_L), M, NIN_PAD, DM, DM, 1 << 20}; pg8::StaticOrder S; S.init(M, NIN_PAD, G, bx);
            pg8::EpiFoxIn E{QB, (size_t)M * DM, LOGF, SSQ + (size_t)(2 * layer) * M, b_f + j2 * NH, qn_g + j2 * HD, kn_g + j2 * HD, attn_body::C2};
            pg8::gemm_phase<pg8::EpiFoxIn>(ldsl, g, S, E, tid);
        } else if (type == 6) {
            const attn_body::AttnTensors AT{(const attn_body::bf16*)QB, (const attn_body::bf16*)(QB + (size_t)M * DM), (const attn_body::bf16*)(QB + 2 * (size_t)M * DM), (attn_body::bf16*)QB,
                                            (const attn_body::bf16*)(QB + 3 * (size_t)M * DM), LOGF};
            attn_body::attn_phase<8>((char*)lds, AT, vcu, G, tid);
        } else if (type == 7) {
            pg8::Gemm g{QB, (const bf16*)(ws + WS_WOUT + j2 * WOUT_L), M, DM, DM, DM, 1 << 20}; pg8::StaticOrder S; S.init(M, DM, G, bx);
            pg8::EpiResid E{H, H, HB, SSQ + (size_t)(2 * layer + 1) * M, nullptr};
            pg8::gemm_phase<pg8::EpiResid>(ldsl, g, S, E, tid);
        } else {
            const float* ssq = SSQ + (size_t)8 * M; const int gw = vcu * NWAVES + wave, NGW = G * NWAVES;
            for (int m = gw; m < M; m += NGW) { const float rs = pg8::rstd_row(ssq, m); f32x4* hr = (f32x4*)(H + (size_t)m * DM) + lane; const f32x4* gr = (const f32x4*)final_g + lane;
#pragma unroll
                for (int j = 0; j < 8; ++j) hr[64 * j] = hr[64 * j] * rs * gr[64 * j]; }
        }
        if (ph + 1 < args.ph_hi) { asm volatile("s_waitcnt vmcnt(0) lgkmcnt(0)" ::: "memory"); grid.sync(); }
    }
}

#ifndef MK_PER_PHASE
#define MK_PER_PHASE 0
#endif
extern "C" void kernel_launch(void* const* d_in, const int* in_sizes, int n_in, void* d_out, int out_size, void* d_ws, size_t ws_size, hipStream_t stream) {
    static int grid = 0;
    if (grid == 0) {
        if (n_in != 13 || in_sizes[0] != M * DM || out_size != M * DM || ws_size < WS_END) { fprintf(stderr, "kernel_launch: unexpected shapes (n_in %d in0 %d out %d ws %zu)\n", n_in, n_in > 0 ? in_sizes[0] : -1, out_size, ws_size); grid = -1; return; }
        int dev = 0, cus = 0, per_cu = 0;
        (void)hipGetDevice(&dev); (void)hipDeviceGetAttribute(&cus, hipDeviceAttributeMultiprocessorCount, dev);
        if (hipFuncSetAttribute((const void*)fwd_kernel, hipFuncAttributeMaxDynamicSharedMemorySize, LDS_BYTES) != hipSuccess) { fprintf(stderr, "kernel_launch: hipFuncSetAttribute failed\n"); grid = -1; return; }
        (void)hipOccupancyMaxActiveBlocksPerMultiprocessor(&per_cu, (const void*)fwd_kernel, NWAVES * 64, LDS_BYTES);
        if (per_cu < 1) { fprintf(stderr, "kernel_launch: occupancy query says %d\n", per_cu); per_cu = 1; }
        (void)hipGetLastError();
        grid = cus * per_cu;
    }
    if (grid < 0) return;
    Args a{};
    for (int i = 0; i < 13; ++i) a.in[i] = (const float*)d_in[i];
    a.out = (float*)d_out; a.ws = (unsigned char*)d_ws;
#if MK_PER_PHASE
    for (int ph = 0; ph < NPHASE; ++ph) { a.ph_lo = ph; a.ph_hi = ph + 1; hipLaunchKernelGGL(fwd_kernel, dim3(grid), dim3(NWAVES * 64), LDS_BYTES, stream, a); }
#else
    a.ph_lo = 0; a.ph_hi = NPHASE;
    void* kargs[] = {&a};
    hipError_t e = hipLaunchCooperativeKernel((const void*)fwd_kernel, dim3(grid), dim3(NWAVES * 64), kargs, LDS_BYTES, stream);
    if (e != hipSuccess) fprintf(stderr, "cooperative launch failed: %s (grid %d)\n", hipGetErrorString(e), grid);
#endif
}
```

```cpp
#include <hip/hip_runtime.h>
#include <hip/hip_cooperative_groups.h>
#include <hip/hip_bf16.h>
#include <cstdio>
#include <cstdint>
#include <cmath>
namespace cg = cooperative_groups;

constexpr int BATCH = 4, SEQ = 4096, DM = 2048, M = BATCH * SEQ, NH = 32, HD = 64, FF = 5632, NGU = 2 * FF, NIN = 4 * DM + NH, NIN_PAD = 8448, PG = 512;
constexpr float RMS_EPS = 1e-6f;

namespace pg8 {
#define PG8_LAS __attribute__((address_space(3)))
typedef unsigned short bf16_t;
typedef short bf16x8 __attribute__((ext_vector_type(8)));
typedef float f32x4 __attribute__((ext_vector_type(4)));
typedef unsigned u32x4 __attribute__((ext_vector_type(4)));
constexpr int BM = 256, BK = 64, HALF = 128, HTB = HALF * BK * 2  , STAGE_BYTES = 8 * HTB, NXCD = 8, WGM = 4;

__host__ __device__ __forceinline__ int lds_byte(int r, int c) { const int st = (r >> 4) * 2 + (c >> 5), rr = r & 15, cc = c & 31, ob = rr * 64 + cc * 2; return st * 1024 + (ob ^ (((ob >> 9) & 1) << 5)); }
__host__ __device__ __forceinline__ void stage_rc(int b, int& R, int& C) { const int st = b / 1024, sb = b % 1024, swz = sb ^ (((sb >> 9) & 1) << 5); R = (st >> 1) * 16 + swz / 64; C = (st & 1) * 32 + (swz % 64) / 2; }
__host__ __device__ __forceinline__ int perm32(int rho) { const int n = rho >> 4, i = rho & 15; return 8 * (i >> 2) + 4 * n + (i & 3); }

struct Unit { int pm, pn; };
struct Gemm { const bf16_t* A; const bf16_t* Bt; int M, N, K, lda, gdiv; };

struct StaticOrder {
    int nM, nN, nwg, G, c;
    __host__ __device__ void init(int M_, int N_, int G_, int c_) { nM = M_ / BM; nN = N_ / BM; nwg = nM * nN; G = G_; c = c_; }
    __host__ __device__ bool next(int i, Unit& u) const {
        const long L = (long)i * G + c; if (L >= nwg) return false;
        int wgid = (int)L; { const int q = nwg / NXCD, r = nwg % NXCD, xcd = wgid % NXCD, off = wgid / NXCD; wgid = (xcd < r ? xcd * (q + 1) : r * (q + 1) + (xcd - r) * q) + off; }
        const int nig = WGM * nN, gid = wgid / nig, fm = gid * WGM, gsz = (nM - fm) < WGM ? (nM - fm) : WGM;
        u.pm = fm + ((wgid % nig) % gsz); u.pn = (wgid % nig) / gsz; return true;
    }
};

__device__ __forceinline__ unsigned cvt_pk_bf16(float lo, float hi) { unsigned r; asm volatile("v_cvt_pk_bf16_f32 %0, %1, %2" : "=v"(r) : "v"(lo), "v"(hi)); return r; }
typedef unsigned long long ssq_t;
constexpr float SSQ_SCALE = 16777216.0f;
__device__ __forceinline__ float rstd_row(const ssq_t* ssq, int row) { return rsqrtf((float)ssq[row] * (1.0f / (SSQ_SCALE * (float)DM)) + RMS_EPS); }
__device__ __forceinline__ float sigmoid_f(float v) { return __builtin_amdgcn_rcpf(1.0f + __builtin_amdgcn_exp2f(-1.4426950408889634f * v)); }

struct EpiFoxIn {
    static constexpr bool PERM = true;
    bf16_t* QKVG; size_t tstride;
    float* logf; const ssq_t* ssq; const float* bf; const float* gq; const float* gk; float qscale;
    __device__ __forceinline__ void operator()(const f32x4 (&acc)[2][2][4][2], const Unit& u, int wr, int wc, int fr, int fq) const {
        const int row0 = u.pm * BM + wr * 64 + fr;
        const int t = u.pn >> 3, head = (u.pn & 7) * 4 + wc;
        bf16_t* base = QKVG + (size_t)t * tstride + head * HD + 8 * fq;
        f32x4 gv[2][2];
#pragma unroll
        for (int bj = 0; bj < 2; ++bj)
#pragma unroll
            for (int n = 0; n < 2; ++n) { gv[bj][n] = (f32x4){1.f, 1.f, 1.f, 1.f};
                if (t < 2) gv[bj][n] = *(const f32x4*)((t == 0 ? gq : gk) + 32 * bj + 8 * fq + 4 * n) * (t == 0 ? qscale : 1.0f); }
#pragma unroll
        for (int ai = 0; ai < 2; ++ai)
#pragma unroll
            for (int m = 0; m < 4; ++m) { const int row = row0 + ai * HALF + m * 16; const float rs = rstd_row(ssq, row);
                f32x4 v[2][2]; float ss = 0.f;
#pragma unroll
                for (int bj = 0; bj < 2; ++bj)
#pragma unroll
                    for (int n = 0; n < 2; ++n) { v[bj][n] = acc[ai][bj][m][n] * rs; const f32x4 q = v[bj][n] * v[bj][n]; ss += (q[0] + q[1]) + (q[2] + q[3]); }
                if (t < 2) { ss += __shfl_xor(ss, 16); ss += __shfl_xor(ss, 32); const float rn = rsqrtf(ss * (1.0f / (float)HD) + RMS_EPS);
#pragma unroll
                    for (int bj = 0; bj < 2; ++bj)
#pragma unroll
                        for (int n = 0; n < 2; ++n) v[bj][n] = v[bj][n] * rn * gv[bj][n]; }
                if (t == 3) {
#pragma unroll
                    for (int bj = 0; bj < 2; ++bj)
#pragma unroll
                        for (int n = 0; n < 2; ++n)
#pragma unroll
                            for (int e = 0; e < 4; ++e) v[bj][n][e] = sigmoid_f(v[bj][n][e]); }
#pragma unroll
                for (int bj = 0; bj < 2; ++bj) { u32x4 w; w.x = cvt_pk_bf16(v[bj][0][0], v[bj][0][1]); w.y = cvt_pk_bf16(v[bj][0][2], v[bj][0][3]); w.z = cvt_pk_bf16(v[bj][1][0], v[bj][1][1]); w.w = cvt_pk_bf16(v[bj][1][2], v[bj][1][3]);
                    *(u32x4*)(base + (size_t)row * DM + 32 * bj) = w; } }
    }
};

struct EpiSwiglu {
    static constexpr bool PERM = true;
    bf16_t* O; const ssq_t* ssq;
    __device__ __forceinline__ void operator()(const f32x4 (&acc)[2][2][4][2], const Unit& u, int wr, int wc, int fr, int fq) const {
        const int row0 = u.pm * BM + wr * 64 + fr, col0 = u.pn * HALF + wc * 32 + 8 * fq;
#pragma unroll
        for (int ai = 0; ai < 2; ++ai)
#pragma unroll
            for (int m = 0; m < 4; ++m) { const int row = row0 + ai * HALF + m * 16; const float rs = rstd_row(ssq, row); f32x4 a[2];
#pragma unroll
                for (int n = 0; n < 2; ++n) { const f32x4 g = acc[ai][0][m][n] * rs, up = acc[ai][1][m][n] * rs;
#pragma unroll
                    for (int e = 0; e < 4; ++e) a[n][e] = g[e] * sigmoid_f(g[e]) * up[e]; }
                u32x4 w; w.x = cvt_pk_bf16(a[0][0], a[0][1]); w.y = cvt_pk_bf16(a[0][2], a[0][3]); w.z = cvt_pk_bf16(a[1][0], a[1][1]); w.w = cvt_pk_bf16(a[1][2], a[1][3]);
                *(u32x4*)(O + (size_t)row * FF + col0) = w; }
    }
};

template <bool HAS_SCALE, bool OUT_F32> struct EpiResid {
    static constexpr bool PERM = true;
    bf16_t* hb; float* outf; ssq_t* ssq_out; const float* colscale;
    __device__ __forceinline__ void operator()(f32x4 (&acc)[2][2][4][2], const Unit& u, int wr, int wc, int fr, int fq) const {
        const int row0 = u.pm * BM + wr * 64 + fr, col0 = u.pn * BM + wc * 32 + 8 * fq;
        if constexpr (HAS_SCALE) {
#pragma unroll
            for (int bj = 0; bj < 2; ++bj)
#pragma unroll
                for (int n = 0; n < 2; ++n) { const f32x4 sc = *(const f32x4*)(colscale + col0 + bj * HALF + 4 * n);
#pragma unroll
                    for (int ai = 0; ai < 2; ++ai)
#pragma unroll
                        for (int m = 0; m < 4; ++m) acc[ai][bj][m][n] = acc[ai][bj][m][n] * sc; }
        }
        u32x4 b[2][2];
#define ER_LOAD(g) _Pragma("unroll") for (int mm = 0; mm < 2; ++mm) _Pragma("unroll") for (int bj = 0; bj < 2; ++bj) b[mm][bj] = *(const u32x4*)(hb + (size_t)(row0 + ((g) >> 1) * HALF + (2 * ((g) & 1) + mm) * 16) * DM + col0 + bj * HALF);
#define ER_COMP(g) _Pragma("unroll") for (int mm = 0; mm < 2; ++mm) _Pragma("unroll") for (int bj = 0; bj < 2; ++bj) { const u32x4 w = b[mm][bj]; \
            acc[(g) >> 1][bj][2 * ((g) & 1) + mm][0] += (f32x4){__uint_as_float(w.x << 16), __uint_as_float(w.x & 0xffff0000u), __uint_as_float(w.y << 16), __uint_as_float(w.y & 0xffff0000u)}; \
            acc[(g) >> 1][bj][2 * ((g) & 1) + mm][1] += (f32x4){__uint_as_float(w.z << 16), __uint_as_float(w.z & 0xffff0000u), __uint_as_float(w.w << 16), __uint_as_float(w.w & 0xffff0000u)}; }
#define ER_STORE(g) _Pragma("unroll") for (int mm = 0; mm < 2; ++mm) { const int ai = (g) >> 1, m = 2 * ((g) & 1) + mm; const int row = row0 + ai * HALF + m * 16; const size_t off = (size_t)row * DM + col0; float ss = 0.f; \
            _Pragma("unroll") for (int bj = 0; bj < 2; ++bj) { const f32x4 o0 = acc[ai][bj][m][0], o1 = acc[ai][bj][m][1]; \
                const f32x4 q0 = o0 * o0, q1 = o1 * o1; ss += ((q0[0] + q0[1]) + (q0[2] + q0[3])) + ((q1[0] + q1[1]) + (q1[2] + q1[3])); \
                if constexpr (OUT_F32) { *(f32x4*)(outf + off + bj * HALF) = o0; *(f32x4*)(outf + off + bj * HALF + 4) = o1; } \
                else { u32x4 v; v.x = cvt_pk_bf16(o0[0], o0[1]); v.y = cvt_pk_bf16(o0[2], o0[3]); v.z = cvt_pk_bf16(o1[0], o1[1]); v.w = cvt_pk_bf16(o1[2], o1[3]); *(u32x4*)(hb + off + bj * HALF) = v; } } \
            ss += __shfl_xor(ss, 16); ss += __shfl_xor(ss, 32); \
            if (fq == 0) (void)__hip_atomic_fetch_add(ssq_out + row, (ssq_t)(ss * SSQ_SCALE), __ATOMIC_RELAXED, __HIP_MEMORY_SCOPE_AGENT); }
#define ER_FENCE asm volatile("" ::: "memory");
        ER_LOAD(0) ER_FENCE ER_COMP(0) ER_FENCE
        ER_LOAD(1) ER_FENCE ER_STORE(0) ER_FENCE ER_COMP(1) ER_FENCE
        ER_LOAD(2) ER_FENCE ER_STORE(1) ER_FENCE ER_COMP(2) ER_FENCE
        ER_LOAD(3) ER_FENCE ER_STORE(2) ER_FENCE ER_COMP(3) ER_FENCE
        ER_STORE(3)
#undef ER_LOAD
#undef ER_COMP
#undef ER_STORE
#undef ER_FENCE
    }
};

template <class Epi>
__device__ __forceinline__ void gemm_phase(PG8_LAS unsigned char* lds, const Gemm g, const StaticOrder& S, const Epi& E, const int tid) {
    const int wid = __builtin_amdgcn_readfirstlane(tid >> 6), lane = tid & 63, wr = wid >> 2, wc = wid & 3, fr = lane & 15, fq = lane >> 4;
    const int K = g.K, nt = K / BK, lda = g.lda;
    unsigned voffA[2], voffB[2];
#pragma unroll
    for (int i = 0; i < 2; ++i) { int R, C; stage_rc(tid * 16 + i * 8192, R, C); const int Rb = Epi::PERM ? ((R & ~31) + perm32(R & 31)) : R;
        voffA[i] = (unsigned)(R * lda + C) * 2u; voffB[i] = (unsigned)(Rb * K + C) * 2u; }
    const size_t kstep = (size_t)(BK * 2);
    const size_t hsA = (size_t)HALF * lda * 2, hsB = (size_t)HALF * K * 2;
    const size_t tsA = 2 * hsA, tsB = 2 * hsB;
    const size_t gsA = (size_t)K * 2;
    const unsigned ldsw = (unsigned)wid * 1024u;
    const int aoff = lds_byte(wr * 64 + fr, fq * 8), boff = lds_byte(wc * 32 + fr, fq * 8);
#define PG8_UA(u) ((const char*)g.A + (size_t)(u).pm * tsA + (size_t)((u).pn / g.gdiv) * gsA)
#define PG8_UB(u) ((const char*)g.Bt + (size_t)(u).pn * tsB)
#define PG8_SA(b, h) (((b) * 2 + (h)) * HTB)
#define PG8_SB(b, h) ((4 + (b) * 2 + (h)) * HTB)
#define PG8_STAGE(bufoff, gbase, voff) do { _Pragma("unroll") for (int _i = 0; _i < 2; ++_i) \
        __builtin_amdgcn_global_load_lds((const unsigned*)((const char*)(gbase) + (voff)[_i]), (PG8_LAS unsigned*)(lds + (bufoff) + ldsw + _i * 8192), 16, 0, 0); } while (0)
#define PG8_LDA(dst, b, h) do { _Pragma("unroll") for (int m = 0; m < 4; ++m) _Pragma("unroll") for (int k = 0; k < 2; ++k) dst[m][k] = *(const PG8_LAS bf16x8*)(lds + PG8_SA(b, h) + aoff + m * 2048 + k * 1024); } while (0)
#define PG8_LDB(dst, b, h) do { _Pragma("unroll") for (int n = 0; n < 2; ++n) _Pragma("unroll") for (int k = 0; k < 2; ++k) dst[n][k] = *(const PG8_LAS bf16x8*)(lds + PG8_SB(b, h) + boff + n * 2048 + k * 1024); } while (0)
#define PG8_MMA(ai, bj, At, Bt) do { __builtin_amdgcn_s_setprio(1); _Pragma("unroll") for (int m = 0; m < 4; ++m) _Pragma("unroll") for (int n = 0; n < 2; ++n) _Pragma("unroll") for (int k = 0; k < 2; ++k) \
        acc[ai][bj][m][n] = __builtin_amdgcn_mfma_f32_16x16x32_bf16(Bt[n][k], At[m][k], acc[ai][bj][m][n], 0, 0, 0); __builtin_amdgcn_s_setprio(0); } while (0)
#define PG8_WAIT_V(n) asm volatile("s_waitcnt vmcnt(" #n ")" ::: "memory")
#define PG8_WAIT_L(n) asm volatile("s_waitcnt lgkmcnt(" #n ")" ::: "memory")
#define PG8_BAR __builtin_amdgcn_s_barrier()
#define PG8_SCHED __builtin_amdgcn_sched_barrier(0)
    Unit cur, nxt; int ui = 0;
    if (!S.next(0, cur)) return;
    f32x4 acc[2][2][4][2];
#pragma unroll
    for (int a = 0; a < 2; ++a)
#pragma unroll
        for (int b = 0; b < 2; ++b)
#pragma unroll
            for (int m = 0; m < 4; ++m)
#pragma unroll
                for (int n = 0; n < 2; ++n) acc[a][b][m][n] = (f32x4){0.f, 0.f, 0.f, 0.f};
    bf16x8 At[4][2], B0[2][2], B1[2][2];
    const char* cA = PG8_UA(cur); const char* cB = PG8_UB(cur);
    PG8_STAGE(PG8_SB(0, 0), cB, voffB); PG8_STAGE(PG8_SB(0, 1), cB + hsB, voffB); PG8_STAGE(PG8_SA(0, 0), cA, voffA); PG8_STAGE(PG8_SA(0, 1), cA + hsA, voffA);
    if (wr == 1) PG8_BAR;
    PG8_WAIT_V(2); PG8_BAR;
    PG8_STAGE(PG8_SB(1, 0), cB + kstep, voffB); PG8_STAGE(PG8_SA(1, 0), cA + kstep, voffA); PG8_STAGE(PG8_SB(1, 1), cB + hsB + kstep, voffB);
    PG8_WAIT_V(6); PG8_BAR;
    for (;;) {
        const bool has_next = S.next(ui + 1, nxt);
        const char* nA = has_next ? PG8_UA(nxt) : cA; const char* nB = has_next ? PG8_UB(nxt) : cB;
        for (int t = 0; t < nt; t += 2) {
            const bool last = (t == nt - 2);
            const char* a1 = cA + (size_t)(t + 1) * kstep;
            const char* a2 = last ? nA : cA + (size_t)(t + 2) * kstep; const char* b2 = last ? nB : cB + (size_t)(t + 2) * kstep;
            const char* a3 = a2 + kstep; const char* b3 = b2 + kstep;
            PG8_LDB(B0, 0, 0); PG8_LDB(B1, 0, 1); PG8_SCHED; PG8_LDA(At, 0, 0); PG8_STAGE(PG8_SA(1, 1), a1 + hsA, voffA);
            PG8_WAIT_V(8); PG8_WAIT_L(0); PG8_BAR; PG8_MMA(0, 0, At, B0); PG8_MMA(0, 1, At, B1); PG8_BAR; PG8_SCHED;
            PG8_LDA(At, 0, 1); PG8_STAGE(PG8_SB(0, 0), b2, voffB); PG8_STAGE(PG8_SB(0, 1), b2 + hsB, voffB); PG8_STAGE(PG8_SA(0, 0), a2, voffA);
            PG8_WAIT_V(8); PG8_WAIT_L(0); PG8_BAR; PG8_MMA(1, 0, At, B0); PG8_MMA(1, 1, At, B1); PG8_BAR; PG8_SCHED;
            PG8_LDB(B0, 1, 0); PG8_LDB(B1, 1, 1); PG8_SCHED; PG8_LDA(At, 1, 0); PG8_STAGE(PG8_SA(0, 1), a2 + hsA, voffA);
            PG8_WAIT_V(8); PG8_WAIT_L(0); PG8_BAR; PG8_MMA(0, 0, At, B0); PG8_MMA(0, 1, At, B1); PG8_BAR; PG8_SCHED;
            PG8_LDA(At, 1, 1); PG8_STAGE(PG8_SB(1, 0), b3, voffB); PG8_STAGE(PG8_SB(1, 1), b3 + hsB, voffB); PG8_STAGE(PG8_SA(1, 0), a3, voffA);
            PG8_WAIT_V(8); PG8_WAIT_L(0); PG8_BAR; PG8_MMA(1, 0, At, B0); PG8_MMA(1, 1, At, B1); PG8_BAR; PG8_SCHED;
        }
        if (wr == 0) PG8_BAR;
        { int fr2 = fr, fq2 = fq; asm volatile("" : "+v"(fr2), "+v"(fq2)); E(acc, cur, wr, wc, fr2, fq2); }
        if (!has_next) break;
#pragma unroll
        for (int a = 0; a < 2; ++a)
#pragma unroll
            for (int b = 0; b < 2; ++b)
#pragma unroll
                for (int m = 0; m < 4; ++m)
#pragma unroll
                    for (int n = 0; n < 2; ++n) acc[a][b][m][n] = (f32x4){0.f, 0.f, 0.f, 0.f};
        cur = nxt; cA = nA; cB = nB; ++ui;
        if (wr == 1) PG8_BAR;
    }
    PG8_WAIT_V(0);
    PG8_BAR;
#undef PG8_UA
#undef PG8_UB
#undef PG8_SA
#undef PG8_SB
#undef PG8_STAGE
#undef PG8_LDA
#undef PG8_LDB
#undef PG8_MMA
#undef PG8_WAIT_V
#undef PG8_WAIT_L
#undef PG8_BAR
#undef PG8_SCHED
}
}

#include <hip/hip_bf16.h>
#include <cmath>
namespace attn_body {
using bf16=__hip_bfloat16;
using bf16x8=__attribute__((ext_vector_type(8)))short;
using s16x4=__attribute__((ext_vector_type(4)))short;
using f32x16=__attribute__((ext_vector_type(16)))float;
using u32x4=__attribute__((ext_vector_type(4)))unsigned;
using f32x4v=__attribute__((ext_vector_type(4)))float;
constexpr int BATCH=4,NHEAD=32,SEQ=4096,D=64,DM=NHEAD*D;
constexpr int NW=8,QBLK=32,QB=QBLK*NW,KVBLK=64,NQB=SEQ/QB;
constexpr int ATTN_PITCH=DM, ATTN_UNIT_ROWS=QB;
__device__ __forceinline__ int crow(int r,int hi){return (r&3)+8*(r>>2)+4*hi;}
#define SBAR() __builtin_amdgcn_sched_barrier(0)
__device__ __forceinline__ void cmask(f32x16&p0,f32x16&p1,int jb,int qrel,int hi){
  const float NEG=-INFINITY; int kb=64*jb+4*hi;
  #pragma unroll
  for(int r=0;r<16;++r){int kv=kb+(r&3)+8*(r>>2); if(kv>qrel)p0[r]=NEG; if(kv+32>qrel)p1[r]=NEG;}
}

constexpr int NSLOT=3, SLOTB=8192;
constexpr int LDS_K=0, LDS_V=NSLOT*SLOTB, LDS_WS=2*NSLOT*SLOTB, LDS_OST=LDS_WS+NW*64*4, LDS_NB=LDS_OST+NW*4096, LDS_WT=LDS_NB+SEQ*4, LDS_BYTES=LDS_WT+64;
constexpr float C2=0.125f*1.4426950408889634f;
__device__ __forceinline__ void glds16(const void*gsrc,unsigned lds_dst){unsigned keep;
  asm volatile("s_mov_b32 %0, m0\n\ts_mov_b32 m0, %2\n\ts_nop 0\n\tglobal_load_lds_dwordx4 %1, off\n\ts_mov_b32 m0, %0":"=&s"(keep):"v"(gsrc),"s"(lds_dst):"memory");}
__device__ __forceinline__ float max3f(float a,float b,float c){float r;asm("v_max3_f32 %0, %1, %2, %3":"=v"(r):"v"(a),"v"(b),"v"(c));return r;}
__device__ __forceinline__ float max2f(float a,float b){float r;asm("v_max_f32_e32 %0, %1, %2":"=v"(r):"v"(a),"v"(b));return r;}
__device__ __forceinline__ float fadd_s(float a,float b){float r;asm("v_add_f32_e32 %0, %1, %2":"=v"(r):"v"(a),"v"(b));return r;}
__device__ __forceinline__ float fsub_s(float a,float b){float r;asm("v_sub_f32_e32 %0, %1, %2":"=v"(r):"v"(a),"v"(b));return r;}
typedef float f32x2_t __attribute__((ext_vector_type(2))); typedef __bf16 bf16x2_t __attribute__((ext_vector_type(2)));
__device__ __forceinline__ unsigned cvtpk_s(float lo,float hi){f32x2_t v={lo,hi};bf16x2_t b=__builtin_convertvector(v,bf16x2_t);return __builtin_bit_cast(unsigned,b);}
#define WAIT_BAR(N) asm volatile("s_waitcnt vmcnt(" #N ") lgkmcnt(0)\n\ts_barrier":::"memory")

__device__ __forceinline__ void qkt(f32x16&p0,f32x16&p1,const char*Kslot,const bf16x8*qr,int r32,int hi){
  const char*kb=Kslot+hi*1024+r32*16;
  #pragma unroll
  for(int d0=0;d0<4;++d0){
    const bf16x8 b0=*reinterpret_cast<const bf16x8*>(kb+d0*2048);
    const bf16x8 b1=*reinterpret_cast<const bf16x8*>(kb+d0*2048+512);
    p0=__builtin_amdgcn_mfma_f32_32x32x16_bf16(b0,qr[d0],p0,0,0,0);p1=__builtin_amdgcn_mfma_f32_32x32x16_bf16(b1,qr[d0],p1,0,0,0);}
}
typedef __attribute__((address_space(3))) const char* lds_cptr;
typedef short v4i16_t __attribute__((ext_vector_type(4)));
__device__ __forceinline__ void kload8(bf16x8*kf,lds_cptr kp){
  kf[0]=*(const __attribute__((address_space(3))) bf16x8*)(kp);      kf[1]=*(const __attribute__((address_space(3))) bf16x8*)(kp+512);
  kf[2]=*(const __attribute__((address_space(3))) bf16x8*)(kp+2048); kf[3]=*(const __attribute__((address_space(3))) bf16x8*)(kp+2560);
  kf[4]=*(const __attribute__((address_space(3))) bf16x8*)(kp+4096); kf[5]=*(const __attribute__((address_space(3))) bf16x8*)(kp+4608);
  kf[6]=*(const __attribute__((address_space(3))) bf16x8*)(kp+6144); kf[7]=*(const __attribute__((address_space(3))) bf16x8*)(kp+6656);
}
__device__ __forceinline__ void kload2(bf16x8*kf,lds_cptr kp,int j){ kf[2*j]=*(const __attribute__((address_space(3))) bf16x8*)(kp+j*2048); kf[2*j+1]=*(const __attribute__((address_space(3))) bf16x8*)(kp+j*2048+512); }
__device__ __forceinline__ s16x4 vtr(lds_cptr p){ return __builtin_bit_cast(s16x4,__builtin_amdgcn_ds_read_tr16_b64_v4i16((__attribute__((address_space(3))) v4i16_t*)p)); }
__device__ __forceinline__ float rowmax(const f32x16&p0,const f32x16&p1){
  float a=max3f(p0[0],p0[1],p1[0]),b=max3f(p0[2],p0[3],p1[1]);a=max3f(a,p1[2],p1[3]);
  #pragma unroll
  for(int r=4;r<16;r+=4){a=max3f(a,p0[r],p0[r+1]);b=max3f(b,p0[r+2],p0[r+3]);a=max3f(a,p1[r],p1[r+1]);b=max3f(b,p1[r+2],p1[r+3]);}
  const float m=max2f(a,b);
  auto rr=__builtin_amdgcn_permlane32_swap(__float_as_uint(m),__float_as_uint(m),false,false);
  return max2f(__uint_as_float(rr[0]),__uint_as_float(rr[1]));
}
__device__ __forceinline__ void pv(f32x16*o,int vb,bf16x8 pa0,bf16x8 pa1,bf16x8 pa2,bf16x8 pa3){
  #pragma unroll
  for(int d0=0;d0<2;++d0){s16x4 lo[4],hi[4];
    #pragma unroll
    for(int ks=0;ks<4;++ks){
      asm volatile("ds_read_b64_tr_b16 %0,%1 offset:%c2":"=&v"(lo[ks]):"v"(vb),"i"(d0*4096+ks*1024):"memory");
      asm volatile("ds_read_b64_tr_b16 %0,%1 offset:%c2":"=&v"(hi[ks]):"v"(vb),"i"(d0*4096+ks*1024+512):"memory");}
    asm volatile("s_waitcnt lgkmcnt(0)":::"memory");SBAR();
    #define PK(k) (bf16x8){lo[k][0],lo[k][1],lo[k][2],lo[k][3],hi[k][0],hi[k][1],hi[k][2],hi[k][3]}
    o[d0]=__builtin_amdgcn_mfma_f32_32x32x16_bf16(pa0,PK(0),o[d0],0,0,0);
    o[d0]=__builtin_amdgcn_mfma_f32_32x32x16_bf16(pa1,PK(1),o[d0],0,0,0);
    o[d0]=__builtin_amdgcn_mfma_f32_32x32x16_bf16(pa2,PK(2),o[d0],0,0,0);
    o[d0]=__builtin_amdgcn_mfma_f32_32x32x16_bf16(pa3,PK(3),o[d0],0,0,0);
    #undef PK
  }
}

#ifndef ATTN_STORE16
#define ATTN_STORE16(p,v) (*(u32x4*)(p)=(v))
#endif
template<int THRL> __device__ __forceinline__ void attn_unit(int b,int h,int qb,int ts,const bf16*Q,const bf16*__restrict__ K,const bf16*__restrict__ V,bf16*O,const bf16*__restrict__ SG,char*shm,const int tid){
  const int lane=tid&63,r32=lane&31,hi=lane>>5; const int wid=__builtin_amdgcn_readfirstlane(tid>>6);
  const long rowbase=(long)b*SEQ; const int q0=qb*QB;
  const bf16*Qw=Q+(rowbase+q0+wid*QBLK)*DM+h*D;
  const bf16*Kh=K+(rowbase+(long)ts*KVBLK)*DM+h*D,*Vh=V+(rowbase+(long)ts*KVBLK)*DM+h*D;
  const lds_cptr shm3=(lds_cptr)shm;
  const unsigned lds0=(unsigned)(uintptr_t)shm;
  float*wsf=(float*)(shm+LDS_WS)+wid*64;
  const bf16*ksrc=Kh+(long)lane*DM+wid*8;
  const bf16*vsrc=Vh+(long)(16*(wid&3)+(lane>>2))*DM+(wid>>2)*32+(lane&3)*8;
  const unsigned kdst=lds0+LDS_K+wid*1024, vdst=lds0+LDS_V+wid*1024;
  #define DMA_K(t,slot) glds16(ksrc+(long)(t)*KVBLK*DM,(unsigned)__builtin_amdgcn_readfirstlane(kdst+(slot)))
  #define DMA_V(t,slot) glds16(vsrc+(long)(t)*KVBLK*DM,(unsigned)__builtin_amdgcn_readfirstlane(vdst+(slot)))
  const int vb0=(int)(lds0+LDS_V)+((lane>>4)&1)*32+(lane&3)*8+(4*hi+((lane&15)>>2))*64;
  const char*Kbase=shm+LDS_K; bf16x8 kf[8];
  const lds_cptr kp0=shm3+LDS_K+hi*1024+r32*16; const lds_cptr vp0=shm3+LDS_V+((lane>>4)&1)*32+(lane&3)*8+(4*hi+((lane&15)>>2))*64;
  const int NT=(q0+QB)/KVBLK-ts;
  DMA_K(0,0);DMA_V(0,0);DMA_K(1,SLOTB);
  bf16x8 qr[4];
  #pragma unroll
  for(int d0=0;d0<4;++d0)qr[d0]=*reinterpret_cast<const bf16x8*>(&Qw[(long)r32*DM+d0*16+hi*8]);
  float l_reg=0.f;f32x16 o[2];o[0]=f32x16{};o[1]=f32x16{};
  const int qrel=wid*QBLK+r32;
  typedef __attribute__((address_space(3))) const f32x4v* nb_ptr; const nb_ptr nbp0=(nb_ptr)(shm3+LDS_NB)+hi+ts*16;
  float negs=-((const __attribute__((address_space(3))) float*)(shm3+LDS_NB))[q0+qrel];
  #define CINIT(C0,C1,t) do{ const nb_ptr bp_=nbp0+(t)*16; _Pragma("unroll") for(int j_=0;j_<4;++j_){ const f32x4v a_=bp_[2*j_], b_=bp_[8+2*j_]; \
      C0[4*j_]=a_[0]+negs; C0[4*j_+1]=a_[1]+negs; C0[4*j_+2]=a_[2]+negs; C0[4*j_+3]=a_[3]+negs; \
      C1[4*j_]=b_[0]+negs; C1[4*j_+1]=b_[1]+negs; C1[4*j_+2]=b_[2]+negs; C1[4*j_+3]=b_[3]+negs; } }while(0)
  #define CMASK(P0,P1,t) do{int jb_=(t)-(NT-4); if(jb_>=0)cmask(P0,P1,jb_,qrel,hi);}while(0)
  bool resc=false;
  #define START(P0,P1) do{ const float rm=rowmax(P0,P1); resc=false; \
    if(__any(rm>(float)THRL)){ const float dl=__builtin_fmaxf(rm,0.f); negs-=dl; \
      _Pragma("unroll") for(int r=0;r<16;++r){P0[r]-=dl;P1[r]-=dl;} } \
    _Pragma("unroll") for(int r=0;r<16;++r)P0[r]=__builtin_amdgcn_exp2f(P0[r]); }while(0)
  #define RESC() do{ if(resc){ asm volatile("s_waitcnt lgkmcnt(0)":::"memory"); \
      _Pragma("unroll") for(int d_=0;d_<2;++d_) _Pragma("unroll") for(int r=0;r<16;++r)o[d_][r]*=wsf[crow(r,hi)]; } }while(0)
  f32x16 pA0,pA1,pB0,pB1;
  int sl_prev=0,sl_cur=0,sl_next=SLOTB;
  #define ROT() do{sl_prev=sl_cur;sl_cur=sl_next;sl_next=(sl_next==(NSLOT-1)*SLOTB)?0:sl_next+SLOTB;}while(0)
  DMA_K(2,2*SLOTB);
  WAIT_BAR(3);
  CINIT(pA0,pA1,0); qkt(pA0,pA1,Kbase,qr,r32,hi);asm volatile("s_nop 15\n\ts_nop 7":"+v"(pA0),"+v"(pA1));CMASK(pA0,pA1,0);
  START(pA0,pA1);
  _Pragma("unroll") for(int r=0;r<16;++r)pA1[r]=__builtin_amdgcn_exp2f(pA1[r]);
  WAIT_BAR(0);
  DMA_K(3,0);DMA_V(1,SLOTB);
  ROT();
  kload8(kf,kp0+sl_cur);
  WAIT_BAR(2);
  s16x4 vlo[8],vhi[8]; u32x4 pw0,pw1,pw2,pw3;
  #define PKW(P,B) cvtpk_s(P[B],P[B+1])
  #define PAF(k) __builtin_bit_cast(bf16x8,pw##k)
  #define VFR(i) (bf16x8){vlo[i][0],vlo[i][1],vlo[i][2],vlo[i][3],vhi[i][0],vhi[i][1],vhi[i][2],vhi[i][3]}
  #define PIN(x) asm volatile("":"+v"(x))
  #define MX3(a,b,c) __builtin_fmaxf(__builtin_fmaxf((a),(b)),(c))
  #define GAPA(MF,A0,A1,A2,A3,W0,W1,PW) do{ MF; sacc+=A0; sacc+=A1; sacc+=A2; sacc+=A3; PIN(sacc); W0; W1; PIN(PW); SBAR(); }while(0)
  #define EX(v) __builtin_amdgcn_exp2f(v)
  #define GAPB(MF,X,B) do{ MF; X[B]=EX(X[B]); X[B+1]=EX(X[B+1]); X[B+2]=EX(X[B+2]); X[B+3]=EX(X[B+3]); PIN(X); SBAR(); }while(0)
  #define VRD(i) do{ vlo[i]=vtr(vp_+(((i)>>2)*4096+((i)&3)*1024)); vhi[i]=vtr(vp_+(((i)>>2)*4096+((i)&3)*1024+512)); }while(0)
  #define KRD(G,j) do{ if(G){ kload2(kf,kp0+sl_next,j); SBAR(); } }while(0)
  #define STEP(C0,C1,P0,P1,t,GK,GV,GL) do{ SBAR(); CINIT(C0,C1,t); SBAR(); \
    const lds_cptr vp_=vp0+sl_prev; \
    VRD(0); SBAR(); float sacc=(P0[0]+P0[1]); \
    GAPA(C0=__builtin_amdgcn_mfma_f32_32x32x16_bf16(kf[0],qr[0],C0,0,0,0), P0[2],P0[3],P0[4],P0[5],     pw0[0]=PKW(P0,0), pw0[1]=PKW(P0,2), pw0); \
    VRD(4); SBAR(); GAPA(C1=__builtin_amdgcn_mfma_f32_32x32x16_bf16(kf[1],qr[0],C1,0,0,0), P0[6],P0[7],P0[8],P0[9],     pw0[2]=PKW(P0,4), pw0[3]=PKW(P0,6), pw0); \
    VRD(1); SBAR(); GAPA(C0=__builtin_amdgcn_mfma_f32_32x32x16_bf16(kf[2],qr[1],C0,0,0,0),   P0[10],P0[11],P0[12],P0[13], pw1[0]=PKW(P0,8), pw1[1]=PKW(P0,10), pw1); \
    VRD(5); SBAR(); GAPA(C1=__builtin_amdgcn_mfma_f32_32x32x16_bf16(kf[3],qr[1],C1,0,0,0),   P0[14],P0[15],P1[0],P1[1],   pw1[2]=PKW(P0,12),pw1[3]=PKW(P0,14), pw1); \
    VRD(2); SBAR(); GAPA(C0=__builtin_amdgcn_mfma_f32_32x32x16_bf16(kf[4],qr[2],C0,0,0,0),   P1[2],P1[3],P1[4],P1[5],     pw2[0]=PKW(P1,0), pw2[1]=PKW(P1,2), pw2); \
    VRD(6); SBAR(); GAPA(C1=__builtin_amdgcn_mfma_f32_32x32x16_bf16(kf[5],qr[2],C1,0,0,0),   P1[6],P1[7],P1[8],P1[9],     pw2[2]=PKW(P1,4), pw2[3]=PKW(P1,6), pw2); \
    VRD(3); SBAR(); GAPA(C0=__builtin_amdgcn_mfma_f32_32x32x16_bf16(kf[6],qr[3],C0,0,0,0),   P1[10],P1[11],P1[12],P1[13], pw3[0]=PKW(P1,8), pw3[1]=PKW(P1,10), pw3); \
    VRD(7); SBAR(); GAPA(C1=__builtin_amdgcn_mfma_f32_32x32x16_bf16(kf[7],qr[3],C1,0,0,0),   P1[14],P1[15],0.f,0.f,       pw3[2]=PKW(P1,12),pw3[3]=PKW(P1,14), pw3); \
    l_reg+=sacc; \
    if(GK){DMA_K((t)+3,sl_cur);} if(GV){DMA_V((t)+1,sl_next);} \
    CMASK(C0,C1,t); \
    { float a=MX3(C0[0],C0[1],C1[0]),b=MX3(C0[2],C0[3],C1[1]); a=MX3(a,C1[2],C1[3]); \
      _Pragma("unroll") for(int r=4;r<16;r+=4){a=MX3(a,C0[r],C0[r+1]);b=MX3(b,C0[r+2],C0[r+3]);a=MX3(a,C1[r],C1[r+1]);b=MX3(b,C1[r+2],C1[r+3]);} \
      float rm=__builtin_fmaxf(a,b); { auto rr=__builtin_amdgcn_permlane32_swap(__float_as_uint(rm),__float_as_uint(rm),false,false); rm=__builtin_fmaxf(__uint_as_float(rr[0]),__uint_as_float(rr[1])); } \
      resc=false; \
      if(__builtin_expect(__any(rm>(float)THRL),0)){ const float dl=__builtin_fmaxf(rm,0.f); \
        _Pragma("unroll") for(int r=0;r<16;++r){C0[r]-=dl;C1[r]-=dl;} \
        negs-=dl; \
        const float f=__builtin_amdgcn_exp2f(-dl); l_reg*=f; if(hi==0)wsf[r32]=f; resc=true; } } \
    SBAR(); \
    GAPB(o[0]=__builtin_amdgcn_mfma_f32_32x32x16_bf16(PAF(0),VFR(0),o[0],0,0,0), C0,0); \
    GAPB(o[1]=__builtin_amdgcn_mfma_f32_32x32x16_bf16(PAF(0),VFR(4),o[1],0,0,0), C0,4); \
    KRD(GL,0); GAPB(o[0]=__builtin_amdgcn_mfma_f32_32x32x16_bf16(PAF(1),VFR(1),o[0],0,0,0), C0,8); \
    KRD(GL,1); GAPB(o[1]=__builtin_amdgcn_mfma_f32_32x32x16_bf16(PAF(1),VFR(5),o[1],0,0,0), C0,12); \
    KRD(GL,2); GAPB(o[0]=__builtin_amdgcn_mfma_f32_32x32x16_bf16(PAF(2),VFR(2),o[0],0,0,0), C1,0); \
    KRD(GL,3); GAPB(o[1]=__builtin_amdgcn_mfma_f32_32x32x16_bf16(PAF(2),VFR(6),o[1],0,0,0), C1,4); \
    GAPB(o[0]=__builtin_amdgcn_mfma_f32_32x32x16_bf16(PAF(3),VFR(3),o[0],0,0,0), C1,8); \
    GAPB(o[1]=__builtin_amdgcn_mfma_f32_32x32x16_bf16(PAF(3),VFR(7),o[1],0,0,0), C1,12); \
    }while(0)
  int t=1;
  #undef CMASK
  #define CMASK(P0,P1,t) do{}while(0)
  for(;t+5<NT;t+=2){
    STEP(pB0,pB1,pA0,pA1,t,true,true,true);     WAIT_BAR(2); RESC(); ROT();
    STEP(pA0,pA1,pB0,pB1,t+1,true,true,true);   WAIT_BAR(2); RESC(); ROT();
  }
  #undef CMASK
  #define CMASK(P0,P1,t) do{int jb_=(t)-(NT-4); if(jb_>=0)cmask(P0,P1,jb_,qrel,hi);}while(0)
  #define ENDW(tt) do{ if((tt)+3<NT){WAIT_BAR(2);} else if((tt)+2<NT){WAIT_BAR(1);} else {WAIT_BAR(0);} }while(0)
  for(;t+1<NT;t+=2){
    STEP(pB0,pB1,pA0,pA1,t,(t+3<NT),(t+1<NT),(t+1<NT));       ENDW(t);   RESC(); ROT();
    STEP(pA0,pA1,pB0,pB1,t+1,(t+4<NT),(t+2<NT),(t+2<NT));     ENDW(t+1); RESC(); ROT();
  }
  STEP(pB0,pB1,pA0,pA1,NT-1,false,false,false); RESC();
  { float sacc=pB0[0]+pB0[1]; _Pragma("unroll") for(int r=2;r<16;++r)sacc+=pB0[r]; _Pragma("unroll") for(int r=0;r<16;++r)sacc+=pB1[r]; l_reg+=sacc;
    pw0=(u32x4){PKW(pB0,0),PKW(pB0,2),PKW(pB0,4),PKW(pB0,6)};pw1=(u32x4){PKW(pB0,8),PKW(pB0,10),PKW(pB0,12),PKW(pB0,14)};pw2=(u32x4){PKW(pB1,0),PKW(pB1,2),PKW(pB1,4),PKW(pB1,6)};pw3=(u32x4){PKW(pB1,8),PKW(pB1,10),PKW(pB1,12),PKW(pB1,14)};
    SBAR(); pv(o,vb0+sl_cur,PAF(0),PAF(1),PAF(2),PAF(3)); }
  #undef PKW
  #undef PAF
  #undef VFR
  #undef PIN
  #undef MX3
  #undef GAPA
  #undef GAPB
  #undef EX
  #undef VRD
  #undef KRD
  #undef STEP
  #undef ENDW
  {auto rr=__builtin_amdgcn_permlane32_swap(__float_as_uint(l_reg),__float_as_uint(l_reg),false,false);l_reg=__uint_as_float(rr[0])+__uint_as_float(rr[1]);}
  if(hi==0)wsf[32+r32]=l_reg;asm volatile("s_waitcnt lgkmcnt(0)":::"memory");
  float rli[16];
  #pragma unroll
  for(int r=0;r<16;++r)rli[r]=__builtin_amdgcn_rcpf(wsf[32+crow(r,hi)]);
  bf16*Ow=O+(rowbase+q0+wid*QBLK)*DM+h*D; const bf16*Gw=SG+(rowbase+q0+wid*QBLK)*DM+h*D;
  { bf16*stg=(bf16*)(shm+LDS_OST)+wid*2048;
    #pragma unroll
    for(int r=0;r<16;++r){const int orow=crow(r,hi);
      #pragma unroll
      for(int d0=0;d0<2;++d0)stg[orow*64+d0*32+r32]=__float2bfloat16(o[d0][r]*rli[r]);}
    asm volatile("s_waitcnt lgkmcnt(0)":::"memory");
    #pragma unroll
    for(int i=0;i<4;++i){const int row=i*8+(lane>>3),ch=lane&7; u32x4 v=*(const u32x4*)(stg+row*64+ch*8); const u32x4 gv=*(const u32x4*)(Gw+(long)row*DM+ch*8);
      #pragma unroll
      for(int e=0;e<4;++e){ const float a0=__uint_as_float(v[e]<<16),a1=__uint_as_float(v[e]&0xffff0000u),g0=__uint_as_float(gv[e]<<16),g1=__uint_as_float(gv[e]&0xffff0000u); v[e]=cvtpk_s(a0*g0,a1*g1); }
      ATTN_STORE16(Ow+(long)row*DM+ch*8,v);} }
  asm volatile("s_waitcnt lgkmcnt(0)\n\ts_barrier":::"memory");
  #undef DMA_K
  #undef DMA_V
  #undef CMASK
  #undef CINIT
  #undef START
  #undef RESC
  #undef ROT
}
constexpr int ATTN_LDS_BYTES=LDS_BYTES;
struct AttnTensors { const bf16* Q; const bf16* K; const bf16* V; bf16* O; const bf16* SG; const float* logf; };
__device__ __forceinline__ void fox_scan(char*shm,const float*__restrict__ logf,int bh,const int tid,float*__restrict__ nbout){
  const int lane=tid&63,wid=tid>>6; const int b=bh/NHEAD,h=bh%NHEAD;
  const float*src=logf+((long)b*SEQ+(long)tid*8)*NHEAD+h; float v[8];
  #pragma unroll
  for(int i=0;i<8;++i)v[i]=src[i*NHEAD];
  #pragma unroll
  for(int i=1;i<8;++i)v[i]+=v[i-1];
  const float tot=v[7]; float sc=tot;
  #pragma unroll
  for(int off=1;off<64;off<<=1){const float o_=__shfl_up(sc,off); if(lane>=off)sc+=o_;}
  float*wt=(float*)(shm+LDS_WT);
  __syncthreads();
  if(lane==63)wt[wid]=sc;
  __syncthreads();
  float woff=0.f;
  #pragma unroll
  for(int w=0;w<8;++w)woff+=(w<wid)?wt[w]:0.f;
  const float excl=woff+sc-tot;
  f32x4v o0,o1; o0[0]=-(excl+v[0])*1.4426950408889634f; o0[1]=-(excl+v[1])*1.4426950408889634f; o0[2]=-(excl+v[2])*1.4426950408889634f; o0[3]=-(excl+v[3])*1.4426950408889634f;
  o1[0]=-(excl+v[4])*1.4426950408889634f; o1[1]=-(excl+v[5])*1.4426950408889634f; o1[2]=-(excl+v[6])*1.4426950408889634f; o1[3]=-(excl+v[7])*1.4426950408889634f;
  f32x4v*dst=(f32x4v*)(nbout+(long)bh*SEQ+tid*8); dst[0]=o0; dst[1]=o1;
  __syncthreads();
}
template<int THRL=8> __device__ __forceinline__ void attn_phase(char*lds,const AttnTensors&T,const int tid0,unsigned*counter,const float*__restrict__ nbg,float thr){
  volatile unsigned*wq=(volatile unsigned*)(lds+LDS_WT)+8;
  for(;;){
    if(tid0==0){ const unsigned u_=__hip_atomic_fetch_add(counter,1u,__ATOMIC_RELAXED,__HIP_MEMORY_SCOPE_AGENT); *wq=u_; }
    __syncthreads();
    const unsigned u=*wq;
    if(u>=(unsigned)(BATCH*NHEAD*NQB))break;
    const int qb=NQB-1-(int)(u/(BATCH*NHEAD)), bh=(int)(u%(BATCH*NHEAD));
    { const f32x4v*src=(const f32x4v*)(nbg+(long)bh*SEQ); f32x4v*dst=(f32x4v*)(lds+LDS_NB); const int n4=(qb+1)*(QB/4); for(int i=tid0;i<n4;i+=NW*64)dst[i]=src[i]; }
    __syncthreads();
    const float*nb=(const float*)(lds+LDS_NB); const int NT0=(QB/KVBLK)*(qb+1); const float ref=nb[qb*QB]-thr;
    int lo=0,hi=NT0; while(lo<hi){ const int mid=(lo+hi)>>1; if(nb[KVBLK*mid+KVBLK-1]<ref)lo=mid+1; else hi=mid; }
    int ts=lo&~1; if(ts>NT0-4)ts=NT0-4;
    int tid=tid0; asm volatile("":"+v"(tid));
    attn_unit<THRL>(bh/NHEAD,bh%NHEAD,qb,ts,T.Q,T.K,T.V,T.O,T.SG,lds,tid);
  }
}
#undef SBAR
#undef WAIT_BAR
}

constexpr size_t MiB = 1u << 20;
constexpr size_t WS_SSQ = 65536;
constexpr size_t WS_LOGF = 2 * MiB;
constexpr size_t WS_WPOOL = 4 * MiB, WPOOL_L = 2 * MiB;
constexpr size_t WS_WOUT = 8 * MiB, WOUT_L = 8 * MiB;
constexpr size_t WS_WIN = 24 * MiB, WIN_L = 33 * MiB;
constexpr size_t WS_WD = 90 * MiB, WD_L = 22 * MiB;
constexpr size_t WS_WGU = 178 * MiB, WGU_L = 44 * MiB;
constexpr size_t WS_HB = 354 * MiB;
constexpr size_t WS_Q = 418 * MiB, ACT_MD = 64 * MiB;
constexpr size_t WS_ACT = 674 * MiB;
constexpr size_t WS_NBG = 850 * MiB;
constexpr size_t WS_END = 852 * MiB;
constexpr size_t CTL_ATTN_CNT = 14336;
static_assert((size_t)NIN_PAD * DM * 2 == WIN_L && (size_t)DM * FF * 2 == WD_L && (size_t)NGU * DM * 2 == WGU_L && (size_t)M * DM * 2 == ACT_MD && (size_t)M * FF * 2 == 176 * MiB, "ws map");

#ifndef SKEW_US
#define SKEW_US 0
#endif
#ifndef PROBE_DUP
#define PROBE_DUP 0
#endif
constexpr int LDS_BYTES = 147456;
constexpr int NWAVES = 8;
static_assert(attn_body::LDS_BYTES <= 131072, "attention LDS");

#define LAS __attribute__((address_space(3)))
typedef unsigned short bf16;
typedef unsigned v4u __attribute__((ext_vector_type(4)));
typedef unsigned v2u __attribute__((ext_vector_type(2)));
typedef float f32x4 __attribute__((ext_vector_type(4)));
#define LDS_WAIT() asm volatile("s_waitcnt lgkmcnt(0)" ::: "memory")
__device__ __forceinline__ unsigned pk2(float lo, float hi) { return pg8::cvt_pk_bf16(lo, hi); }
__device__ __forceinline__ float wave_sum(float v) {
#pragma unroll
    for (int o = 1; o < 64; o <<= 1) v += __shfl_xor(v, o);
    return v;
}

__device__ __forceinline__ int map_row_gu(int n) { const int j = n < FF ? n : n - FF; return (j >> 7) * 256 + (n < FF ? 0 : 128) + (j & 127); }
__device__ __forceinline__ int map_row_in(int n) { if (n >= 4 * DM) return n; const int t = n >> 11, r = n & 2047, head = r >> 6, d = r & 63; return (t * 8 + (head >> 2)) * 256 + (d >> 5) * 128 + (head & 3) * 32 + (d & 31); }
template <int MAP> __device__ __forceinline__ void tr_item(const float* __restrict__ W, int K, int N, bf16* __restrict__ WT, const float* __restrict__ gain, LAS float* scr, int kb, int nb, int lane) {
    const int k0 = kb * 64, n0 = nb * 64, n4 = lane & 15, kr = lane >> 4;
    const bool nok = (n0 + 4 * n4) < N;
#pragma unroll 8
    for (int i = 0; i < 16; ++i) { const int kk = 4 * i + kr; f32x4 v = (f32x4){0.f, 0.f, 0.f, 0.f};
        if (nok) v = *(const f32x4*)(W + (size_t)(k0 + kk) * N + n0 + 4 * n4);
        if (gain) v = v * gain[k0 + kk];
        LAS float* s = scr + kk * 65 + 4 * n4; s[0] = v[0]; s[1] = v[1]; s[2] = v[2]; s[3] = v[3]; }
    LDS_WAIT();
    const int c = lane & 7;
#pragma unroll
    for (int j = 0; j < 8; ++j) { const int n = (lane >> 3) + 8 * j;
        if (n0 + n < N) { const LAS float* s = scr + (8 * c) * 65 + n;
            v4u o; o.x = pk2(s[0 * 65], s[1 * 65]); o.y = pk2(s[2 * 65], s[3 * 65]); o.z = pk2(s[4 * 65], s[5 * 65]); o.w = pk2(s[6 * 65], s[7 * 65]);
            const int nn = n0 + n; const int row = MAP == 1 ? map_row_gu(nn) : (MAP == 2 ? map_row_in(nn) : nn);
            *(v4u*)(WT + (size_t)row * K + k0 + 8 * c) = o; } }
    LDS_WAIT();
}

constexpr size_t WS_CTL = 0, CTL_ZERO_BYTES = 16384;
constexpr int MISC_OFF = LDS_BYTES - 64;
#define GAS __attribute__((address_space(1)))
typedef GAS unsigned gu32;
typedef GAS unsigned long long gu64;
#define RLX_AGENT __ATOMIC_RELAXED, __HIP_MEMORY_SCOPE_AGENT
#define VM_WAIT() asm volatile("s_waitcnt vmcnt(0)" ::: "memory")
__device__ __forceinline__ unsigned long long rt() { return __builtin_amdgcn_s_memrealtime(); }
#define XB_TMO      128
#define XB_XCNT(j)  (256  + 64 * (j))
#define XB_XSUB(j)  (1280 + 64 * (j))
#define XB_XGEN(j)  (2304 + 64 * (j))
#define XB_TOP      3328
#define XB_TOPGEN   3392
#define XCD_BAR_WORDS 3456
#define XB_SPIN_CAP (1u << 18)

__device__ __forceinline__ unsigned xb_ld(unsigned* p)              { return __hip_atomic_load(p, __ATOMIC_RELAXED, __HIP_MEMORY_SCOPE_AGENT); }
__device__ __forceinline__ unsigned xb_add(unsigned* p, unsigned v) { return __hip_atomic_fetch_add(p, v, __ATOMIC_RELAXED, __HIP_MEMORY_SCOPE_AGENT); }
__device__ __forceinline__ unsigned xb_xcc_id() { return (unsigned)__builtin_amdgcn_s_getreg((3 << 11) | 20) & 0xFu; }
#define XB_SPIN(cond, bar) do { unsigned _sp = 0; while (cond) { __builtin_amdgcn_s_sleep(1); \
    if ((++_sp & 255u) == 0u) { if (xb_ld(&(bar)[XB_TMO])) break; if (_sp > XB_SPIN_CAP) { atomicAdd(&(bar)[XB_TMO], 1u); break; } } } } while (0)

struct XcdBarrier {
    unsigned* bar; unsigned x;
    volatile LAS unsigned* st;
};

__device__ __forceinline__ XcdBarrier xcd_barrier_post(unsigned* bar, volatile LAS unsigned* st) {
    XcdBarrier b; b.bar = bar; b.x = xb_xcc_id(); b.st = st;
    if (threadIdx.x == 0) (void)xb_add(&bar[XB_XCNT(b.x)], 1u);
    return b;
}
__device__ __forceinline__ void xcd_barrier_complete(unsigned* bar, unsigned x, unsigned& nloc, unsigned& nx) {
    const unsigned G = gridDim.x * gridDim.y * gridDim.z;
    unsigned sum, cnt, mine, sp = 0u;
    for (;;) {
        sum = 0u; cnt = 0u; mine = 0u;
#pragma unroll
        for (unsigned j = 0; j < 16; ++j) { const unsigned c = xb_ld(&bar[XB_XCNT(j)]); sum += c; cnt += (c > 0u) ? 1u : 0u; mine = (j == x) ? c : mine; }
        if (sum == G) break;
        __builtin_amdgcn_s_sleep(1);
        if ((++sp & 255u) == 0u) { if (xb_ld(&bar[XB_TMO])) break; if (sp > XB_SPIN_CAP) { atomicAdd(&bar[XB_TMO], 1u); break; } }
    }
    nloc = mine > 0u ? mine : 1u; nx = cnt > 0u ? cnt : 1u;
}

__device__ __forceinline__ void xcd_barrier(const XcdBarrier& b) {
    asm volatile("s_waitcnt vmcnt(0)" ::: "memory");
    __syncthreads();
    if (threadIdx.x == 0) {
        unsigned* bar = b.bar;
        __builtin_amdgcn_s_waitcnt(0);
        unsigned nloc = b.st[0], nx = b.st[1];
        if (nloc == 0u) { xcd_barrier_complete(bar, b.x, nloc, nx); b.st[0] = nloc; b.st[1] = nx; }
        const unsigned old = xb_add(&bar[XB_XSUB(b.x)], 1u);
        const unsigned gen = old / nloc;
        if (old + 1u == (gen + 1u) * nloc) {
            __builtin_amdgcn_fence(__ATOMIC_RELEASE, "agent");
            asm volatile("s_waitcnt vmcnt(0)" ::: "memory");
            const unsigned og = xb_add(&bar[XB_TOP], 1u);
            const unsigned tg = og / nx;
            if (og + 1u == (tg + 1u) * nx) xb_add(&bar[XB_TOPGEN], 1u);
            else XB_SPIN(xb_ld(&bar[XB_TOPGEN]) == tg, bar);
            __builtin_amdgcn_fence(__ATOMIC_ACQUIRE, "agent");
            xb_add(&bar[XB_XGEN(b.x)], 1u);
            asm volatile("s_waitcnt vmcnt(0)" ::: "memory");
        } else {
            XB_SPIN(xb_ld(&bar[XB_XGEN(b.x)]) == gen, bar);
            __builtin_amdgcn_fence(__ATOMIC_ACQUIRE, "agent");
            asm volatile("s_waitcnt vmcnt(0)" ::: "memory");
        }
    }
    __syncthreads();
}

struct Args { const float* in[15]; int ph_lo, ph_hi; };

constexpr int NPHASE = 20;
__device__ __forceinline__ void phase_info(int ph, int& type, int& layer) {
    if (ph == 0) { type = 0; layer = 0; return; }
    if (ph == NPHASE - 1) { type = 8; layer = 0; return; }
    int p = ph - 1; int l = 0;
    if (p >= 4) { p -= 4; l = 1; if (p >= 5) { p -= 5; l = 2; if (p >= 4) { p -= 4; l = 3; } } }
    layer = l;
    if ((l & 1) == 0) type = (p == 0) ? 1 : (p == 1) ? 2 : (p == 2) ? 3 : 4;
    else type = (p == 0) ? 5 : (p == 1) ? 6 : (p == 2) ? 7 : (p == 3) ? 3 : 4;
}

__global__ void __launch_bounds__(NWAVES * 64, 2) fwd_kernel(Args args) {
    extern __shared__ __attribute__((aligned(16))) unsigned char lds[];
    cg::grid_group grid = cg::this_grid();
    LAS unsigned char* ldsl = (LAS unsigned char*)lds;
    volatile LAS unsigned* MISC = (volatile LAS unsigned*)(ldsl + MISC_OFF);
    if (threadIdx.x < 16) MISC[threadIdx.x] = 0u;
    __syncthreads();
    XcdBarrier bar = xcd_barrier_post((unsigned*)((unsigned char*)args.in[14] + WS_CTL), MISC);

    for (int ph = args.ph_lo; ph < args.ph_hi; ++ph) {
        int php = ph; bool dry = false;
        if (PROBE_DUP >> 1) { int cnt = 0; for (php = 0; php < NPHASE; ++php) { const int n = 1 + (((PROBE_DUP >> 1) >> php) & 1); if (ph < cnt + n) { dry = (n == 2 && ph == cnt); break; } cnt += n; } }
        int type, layer; phase_info(php, type, layer);
        int tid = threadIdx.x; asm volatile("" : "+v"(tid)); int bx = blockIdx.x; asm volatile("" : "+s"(bx)); int G = gridDim.x; asm volatile("" : "+s"(G));
        const int lane = tid & 63, wave = __builtin_amdgcn_readfirstlane(tid >> 6);
        const int vcu = (G % 8 == 0) ? (bx % 8) * (G / 8) + bx / 8 : bx;
        const int j2 = layer >> 1;
        int z = 0; asm volatile("" : "+s"(z));
        unsigned char* ws = (unsigned char*)args.in[14 + z];
        const float* x = args.in[0 + z]; const float* attn_g = args.in[1 + z]; const float* ffn_g = args.in[2 + z]; const float* final_g = args.in[3 + z];
        const float* pool_w = args.in[4 + z]; const float* pool_scale = args.in[5 + z]; const float* w_in = args.in[6 + z]; const float* b_f = args.in[7 + z];
        const float* qn_g = args.in[8 + z]; const float* kn_g = args.in[9 + z]; const float* w_out = args.in[10 + z]; const float* w_gu = args.in[11 + z]; const float* w_dn = args.in[12 + z];
        float* H = (float*)args.in[13 + z];
        pg8::ssq_t* SSQ = (pg8::ssq_t*)(ws + WS_SSQ); float* LOGF = (float*)(ws + WS_LOGF);
        bf16* HB = (bf16*)(ws + WS_HB); bf16* QB = (bf16*)(ws + WS_Q); bf16* ACT = (bf16*)(ws + WS_ACT);
        if (SKEW_US > 0 && (type == 2 || type == 4 || type == 7)) {
            const unsigned long long t0 = __builtin_amdgcn_s_memrealtime(), dt = (unsigned long long)((vcu & 3) * SKEW_US * 100);
            while (__builtin_amdgcn_s_memrealtime() - t0 < dt) __builtin_amdgcn_s_sleep(16);
        }
        switch (type) {
        case 0: {
            LAS float* scr = (LAS float*)(ldsl + wave * 16640);
            const int gw = vcu * NWAVES + wave, NGW = G * NWAVES;
            constexpr int I_GU = 32 * 176, I_DN = 88 * 32, I_IN = 32 * 129, I_OUT = 32 * 32, I_PL = 8 * 8;
            constexpr int T_GU = 4 * I_GU, T_DN = 4 * I_DN, T_IN = 2 * I_IN, T_OUT = 2 * I_OUT, T_PL = 8 * I_PL;
            for (int it = gw; it < T_GU + T_DN + T_IN + T_OUT + T_PL; it += NGW) {
                int r = it;
                if (r < T_GU) { const int l = r / I_GU; r %= I_GU; tr_item<1>(w_gu + (size_t)l * DM * NGU, DM, NGU, (bf16*)(ws + WS_WGU + l * WGU_L), ffn_g + l * DM, scr, (r / (8 * 176)) * 8 + (r & 7), (r % (8 * 176)) >> 3, lane); continue; } r -= T_GU;
                if (r < T_DN) { const int l = r / I_DN; r %= I_DN; tr_item<0>(w_dn + (size_t)l * FF * DM, FF, DM, (bf16*)(ws + WS_WD + l * WD_L), nullptr, scr, (r / (8 * 32)) * 8 + (r & 7), (r % (8 * 32)) >> 3, lane); continue; } r -= T_DN;
                if (r < T_IN) { const int l = r / I_IN; r %= I_IN; tr_item<2>(w_in + (size_t)l * DM * NIN, DM, NIN, (bf16*)(ws + WS_WIN + l * WIN_L), attn_g + (2 * l + 1) * DM, scr, (r / (8 * 129)) * 8 + (r & 7), (r % (8 * 129)) >> 3, lane); continue; } r -= T_IN;
                if (r < T_OUT) { const int l = r / I_OUT; r %= I_OUT; tr_item<0>(w_out + (size_t)l * DM * DM, DM, DM, (bf16*)(ws + WS_WOUT + l * WOUT_L), nullptr, scr, (r / (8 * 32)) * 8 + (r & 7), (r % (8 * 32)) >> 3, lane); continue; } r -= T_OUT;
                { const int lg = r / I_PL; r %= I_PL; tr_item<0>(pool_w + (size_t)lg * PG * PG, PG, PG, (bf16*)(ws + WS_WPOOL) + (size_t)lg * PG * PG, nullptr, scr, (r / (8 * 8)) * 8 + (r & 7), (r % (8 * 8)) >> 3, lane); }
            }
            for (int m = gw; m < M; m += NGW) {
                const f32x4* xr = (const f32x4*)(x + (size_t)m * DM) + lane; float s = 0.f; f32x4 v[8];
#pragma unroll
                for (int j = 0; j < 8; ++j) { v[j] = xr[64 * j]; const f32x4 q = v[j] * v[j]; s += (q[0] + q[1]) + (q[2] + q[3]); }
                s = wave_sum(s);
                v2u* o8 = (v2u*)(HB + (size_t)m * DM) + lane;
#pragma unroll
                for (int j = 0; j < 8; ++j) { v2u w; w.x = pk2(v[j][0], v[j][1]); w.y = pk2(v[j][2], v[j][3]); o8[64 * j] = w; }
                if (lane == 0) SSQ[m] = (pg8::ssq_t)(s * pg8::SSQ_SCALE);
            }
            for (int i = bx * (NWAVES * 64) + tid; i < 8 * M; i += G * NWAVES * 64) SSQ[M + i] = 0ull;
        } break;
        case 1: {
            const pg8::ssq_t* ssq = SSQ + (size_t)(2 * layer) * M;
            const int c4 = tid * 4, win = 2 << (tid >> 7);
            const f32x4 g4 = *(const f32x4*)(attn_g + layer * DM + c4);
#define HN_ROW(r) ({ const v2u w_ = *(const v2u*)(HB + (size_t)(r) * DM + c4); (f32x4){__uint_as_float(w_.x << 16), __uint_as_float(w_.x & 0xffff0000u), __uint_as_float(w_.y << 16), __uint_as_float(w_.y & 0xffff0000u)} * pg8::rstd_row(ssq, (r)); })
            for (int ch = vcu; ch < M / 64; ch += G) {
                const int t0 = ch * 64, tp0 = t0 & (SEQ - 1);
                f32x4 s = (f32x4){0.f, 0.f, 0.f, 0.f};
                for (int j = 1; j < win; ++j) if (tp0 - j >= 0) s += HN_ROW(t0 - j);
                s = s * g4;
#pragma unroll 8
                for (int i = 0; i < 64; ++i) { const int r = t0 + i;
                    const f32x4 v = HN_ROW(r) * g4;
                    s += v; const int cnt = min(tp0 + i + 1, win); const f32x4 f = s * (1.0f / (float)cnt) - v;
                    v2u w; w.x = pk2(f[0], f[1]); w.y = pk2(f[2], f[3]); *(v2u*)(QB + (size_t)r * DM + c4) = w;
                    if (tp0 + i - (win - 1) >= 0) s -= HN_ROW(r - (win - 1)) * g4; }
            }
#undef HN_ROW
        } break;
        case 2: {
            pg8::Gemm g{QB, (const bf16*)(ws + WS_WPOOL + j2 * WPOOL_L), M, DM, PG, DM, 2}; pg8::StaticOrder S; S.init(M, DM, G, bx);
            pg8::EpiResid<true, false> E{HB, nullptr, SSQ + (size_t)(2 * layer + 1) * M, pool_scale + j2 * DM};
            pg8::gemm_phase<pg8::EpiResid<true, false>>(ldsl, g, S, E, tid);
        } break;
        case 3: {
            pg8::Gemm g{HB, (const bf16*)(ws + WS_WGU + layer * WGU_L), M, NGU, DM, DM, 1 << 20}; pg8::StaticOrder S; S.init(M, NGU, G, bx);
            pg8::EpiSwiglu E{ACT, SSQ + (size_t)(2 * layer + 1) * M};
            pg8::gemm_phase<pg8::EpiSwiglu>(ldsl, g, S, E, tid);
        } break;
        case 4: case 7: {
            pg8::Gemm g{ACT, (type == 4) ? (const bf16*)(ws + WS_WD + layer * WD_L) : (const bf16*)(ws + WS_WOUT + j2 * WOUT_L), M, DM, (type == 4) ? FF : DM, (type == 4) ? FF : DM, 1 << 20};
            pg8::StaticOrder S; S.init(M, DM, G, bx);
            pg8::EpiResid<false, false> E{HB, nullptr, SSQ + (size_t)(2 * layer + ((type == 4) ? 2 : 1)) * M, nullptr};
            pg8::gemm_phase<pg8::EpiResid<false, false>>(ldsl, g, S, E, tid);
        } break;
        case 5: {
            pg8::Gemm g{HB, (const bf16*)(ws + WS_WIN + j2 * WIN_L), M, 4 * DM, DM, DM, 1 << 20}; pg8::StaticOrder S; S.init(M, 4 * DM, G, bx);
            pg8::EpiFoxIn E{QB, (size_t)M * DM, LOGF, SSQ + (size_t)(2 * layer) * M, b_f + j2 * NH, qn_g + j2 * HD, kn_g + j2 * HD, attn_body::C2};
            pg8::gemm_phase<pg8::EpiFoxIn>(ldsl, g, S, E, tid);
            {
                typedef float f32x16 __attribute__((ext_vector_type(16))); typedef short bf16x8v __attribute__((ext_vector_type(8)));
                const int r32 = lane & 31, hi = lane >> 5; const bf16* Wf = (const bf16*)(ws + WS_WIN + j2 * WIN_L) + (size_t)(4 * DM) * DM;
                const pg8::ssq_t* ssq = SSQ + (size_t)(2 * layer) * M; LAS float* red = (LAS float*)ldsl;
                for (int rb = vcu; rb < M / 64; rb += G) {
                    f32x16 d0 = {}, d1 = {};
                    const bf16* a0p = HB + (size_t)(rb * 64 + r32) * DM + wave * 256 + 8 * hi; const bf16* bp = Wf + (size_t)r32 * DM + wave * 256 + 8 * hi;
#pragma unroll 8
                    for (int ks = 0; ks < 16; ++ks) { const bf16x8v a0 = *(const bf16x8v*)(a0p + ks * 16), a1 = *(const bf16x8v*)(a0p + (size_t)32 * DM + ks * 16), b = *(const bf16x8v*)(bp + ks * 16);
                        d0 = __builtin_amdgcn_mfma_f32_32x32x16_bf16(a0, b, d0, 0, 0, 0); d1 = __builtin_amdgcn_mfma_f32_32x32x16_bf16(a1, b, d1, 0, 0, 0); }
#pragma unroll
                    for (int r = 0; r < 16; ++r) { red[((wave * 2 + 0) * 16 + r) * 64 + lane] = d0[r]; red[((wave * 2 + 1) * 16 + r) * 64 + lane] = d1[r]; }
                    __syncthreads();
                    { const int blk = tid >> 8, l2 = tid & 63, q4 = (tid >> 6) & 3, j = l2 & 31, h2 = l2 >> 5; const float bias = b_f[j2 * NH + j];
#pragma unroll
                      for (int rr = 0; rr < 4; ++rr) { const int r = 4 * q4 + rr; float s = 0.f;
#pragma unroll
                          for (int w = 0; w < 8; ++w) s += red[((w * 2 + blk) * 16 + r) * 64 + l2];
                          const int row = rb * 64 + blk * 32 + (r & 3) + 8 * (r >> 2) + 4 * h2;
                          const float zv = s * pg8::rstd_row(ssq, row) + bias;
                          LOGF[(size_t)row * NH + j] = fminf(zv, 0.f) - __logf(1.0f + __expf(-fabsf(zv))); } }
                    __syncthreads();
                }
            }
        } break;
        case 6: {
            const attn_body::AttnTensors AT{(const attn_body::bf16*)QB, (const attn_body::bf16*)(QB + (size_t)M * DM), (const attn_body::bf16*)(QB + 2 * (size_t)M * DM), (attn_body::bf16*)ACT,
                                            (const attn_body::bf16*)(QB + 3 * (size_t)M * DM), LOGF};
            float* NBG = (float*)(ws + WS_NBG);
            for (int bh = vcu; bh < BATCH * NH; bh += G) attn_body::fox_scan((char*)lds, LOGF, bh, tid, NBG);
            asm volatile("s_waitcnt vmcnt(0) lgkmcnt(0)" ::: "memory"); xcd_barrier(bar);
            float gqm = 0.f, gkm = 0.f;
            for (int i = 0; i < HD; ++i) { gqm = fmaxf(gqm, fabsf(qn_g[j2 * HD + i])); gkm = fmaxf(gkm, fabsf(kn_g[j2 * HD + i])); }
            const float thr = 2.0f * (8.0f * gqm * gkm * 1.4426950408889634f * 1.02f) + 40.0f;
            attn_body::attn_phase<8>((char*)lds, AT, tid, (unsigned*)(ws + WS_CTL + CTL_ATTN_CNT + j2 * 256), NBG, thr);
        } break;
        default: {
            const pg8::ssq_t* ssq = SSQ + (size_t)8 * M; const int gw = vcu * NWAVES + wave, NGW = G * NWAVES;
            for (int m = gw; m < M; m += NGW) { const float rs = pg8::rstd_row(ssq, m); f32x4* hr = (f32x4*)(H + (size_t)m * DM) + lane; const f32x4* gr = (const f32x4*)final_g + lane; const v2u* br = (const v2u*)(HB + (size_t)m * DM) + lane;
#pragma unroll
                for (int j = 0; j < 8; ++j) { const v2u w = br[64 * j]; hr[64 * j] = (f32x4){__uint_as_float(w.x << 16), __uint_as_float(w.x & 0xffff0000u), __uint_as_float(w.y << 16), __uint_as_float(w.y & 0xffff0000u)} * rs * gr[64 * j]; } }
        } break;
        }
        if (ph + 1 < args.ph_hi) { asm volatile("s_waitcnt vmcnt(0) lgkmcnt(0)" ::: "memory"); if (ph == args.ph_lo) grid.sync(); else xcd_barrier(bar); if (PROBE_DUP & 1) xcd_barrier(bar); }
    }
}

#ifndef MK_PER_PHASE
#define MK_PER_PHASE 0
#endif
extern "C" void kernel_launch(void* const* d_in, const int* in_sizes, int n_in, void* d_out, int out_size, void* d_ws, size_t ws_size, hipStream_t stream) {
    static int grid = 0;
    if (grid == 0) {
        if (n_in != 13 || in_sizes[0] != M * DM || out_size != M * DM || ws_size < WS_END) { fprintf(stderr, "kernel_launch: unexpected shapes (n_in %d in0 %d out %d ws %zu)\n", n_in, n_in > 0 ? in_sizes[0] : -1, out_size, ws_size); grid = -1; return; }
        int dev = 0, cus = 0, per_cu = 0;
        (void)hipGetDevice(&dev); (void)hipDeviceGetAttribute(&cus, hipDeviceAttributeMultiprocessorCount, dev);
        if (hipFuncSetAttribute((const void*)fwd_kernel, hipFuncAttributeMaxDynamicSharedMemorySize, LDS_BYTES) != hipSuccess) { fprintf(stderr, "kernel_launch: hipFuncSetAttribute failed\n"); grid = -1; return; }
        (void)hipOccupancyMaxActiveBlocksPerMultiprocessor(&per_cu, (const void*)fwd_kernel, NWAVES * 64, LDS_BYTES);
        if (per_cu < 1) { fprintf(stderr, "kernel_launch: occupancy query says %d\n", per_cu); per_cu = 1; }
        (void)hipGetLastError();
        grid = cus * per_cu;
    }
    if (grid < 0) return;
    if (hipMemsetAsync((char*)d_ws + WS_CTL, 0, CTL_ZERO_BYTES, stream) != hipSuccess) { fprintf(stderr, "kernel_launch: memset failed\n"); return; }
    Args a{};
    for (int i = 0; i < 13; ++i) a.in[i] = (const float*)d_in[i];
    a.in[13] = (const float*)d_out; a.in[14] = (const float*)d_ws;
#if MK_PER_PHASE
    for (int ph = 0; ph < NPHASE; ++ph) { a.ph_lo = ph; a.ph_hi = ph + 1; hipLaunchKernelGGL(fwd_kernel, dim3(grid), dim3(NWAVES * 64), LDS_BYTES, stream, a); }
#else
    a.ph_lo = 0; a.ph_hi = NPHASE + __builtin_popcount((unsigned)PROBE_DUP >> 1);
    void* kargs[] = {&a};
    hipError_t e = hipLaunchCooperativeKernel((const void*)fwd_kernel, dim3(grid), dim3(NWAVES * 64), kargs, LDS_BYTES, stream);
    if (e != hipSuccess) fprintf(stderr, "cooperative launch failed: %s (grid %d)\n", hipGetErrorString(e), grid);
#endif
}
```

```cpp
#include <hip/hip_runtime.h>
#include <hip/hip_cooperative_groups.h>
#include <hip/hip_bf16.h>
#include <cstdio>
#include <cstdint>
#include <cmath>
namespace cg = cooperative_groups;

constexpr int BATCH = 4, SEQ = 4096, DM = 2048, M = BATCH * SEQ, NH = 32, HD = 64, FF = 5632, NGU = 2 * FF, NIN = 4 * DM + NH, NIN_PAD = 8448, PG = 512;
constexpr float RMS_EPS = 1e-6f;

namespace pg8 {
#define PG8_LAS __attribute__((address_space(3)))
typedef unsigned short bf16_t;
typedef short bf16x8 __attribute__((ext_vector_type(8)));
typedef float f32x4 __attribute__((ext_vector_type(4)));
typedef unsigned u32x4 __attribute__((ext_vector_type(4)));
constexpr int BM = 256, BK = 64, HALF = 128, HTB = HALF * BK * 2  , STAGE_BYTES = 8 * HTB, NXCD = 8, WGM = 4;

__host__ __device__ __forceinline__ int lds_byte(int r, int c) { const int st = (r >> 4) * 2 + (c >> 5), rr = r & 15, cc = c & 31, ob = rr * 64 + cc * 2; return st * 1024 + (ob ^ (((ob >> 9) & 1) << 5)); }
__host__ __device__ __forceinline__ void stage_rc(int b, int& R, int& C) { const int st = b / 1024, sb = b % 1024, swz = sb ^ (((sb >> 9) & 1) << 5); R = (st >> 1) * 16 + swz / 64; C = (st & 1) * 32 + (swz % 64) / 2; }
__host__ __device__ __forceinline__ int perm32(int rho) { const int n = rho >> 4, i = rho & 15; return 8 * (i >> 2) + 4 * n + (i & 3); }

struct Unit { int pm, pn; };
struct Gemm { const bf16_t* A; const bf16_t* Bt; int M, N, K, lda, gdiv; };

struct StaticOrder {
    int nM, nN, nwg, G, c;
    __host__ __device__ void init(int M_, int N_, int G_, int c_) { nM = M_ / BM; nN = N_ / BM; nwg = nM * nN; G = G_; c = c_; }
    __host__ __device__ bool next(int i, Unit& u) const {
        const long L = (long)i * G + c; if (L >= nwg) return false;
        int wgid = (int)L; { const int q = nwg / NXCD, r = nwg % NXCD, xcd = wgid % NXCD, off = wgid / NXCD; wgid = (xcd < r ? xcd * (q + 1) : r * (q + 1) + (xcd - r) * q) + off; }
        const int nig = WGM * nN, gid = wgid / nig, fm = gid * WGM, gsz = (nM - fm) < WGM ? (nM - fm) : WGM;
        u.pm = fm + ((wgid % nig) % gsz); u.pn = (wgid % nig) / gsz; return true;
    }
};

__device__ __forceinline__ unsigned cvt_pk_bf16(float lo, float hi) { unsigned r; asm volatile("v_cvt_pk_bf16_f32 %0, %1, %2" : "=v"(r) : "v"(lo), "v"(hi)); return r; }
typedef unsigned long long ssq_t;
constexpr float SSQ_SCALE = 16777216.0f;
__device__ __forceinline__ float rstd_row(const ssq_t* ssq, int row) { return rsqrtf((float)ssq[row] * (1.0f / (SSQ_SCALE * (float)DM)) + RMS_EPS); }
__device__ __forceinline__ float sigmoid_f(float v) { return __builtin_amdgcn_rcpf(1.0f + __builtin_amdgcn_exp2f(-1.4426950408889634f * v)); }

struct EpiFoxIn {
    static constexpr bool PERM = true;
    bf16_t* QKVG; size_t tstride;
    float* logf; const ssq_t* ssq; const float* bf; const float* gq; const float* gk; float qscale;
    __device__ __forceinline__ void operator()(const f32x4 (&acc)[2][2][4][2], const Unit& u, int wr, int wc, int fr, int fq) const {
        const int row0 = u.pm * BM + wr * 64 + fr;
        const int t = u.pn >> 3, head = (u.pn & 7) * 4 + wc;
        bf16_t* base = QKVG + (size_t)t * tstride + head * HD + 8 * fq;
        f32x4 gv[2][2];
#pragma unroll
        for (int bj = 0; bj < 2; ++bj)
#pragma unroll
            for (int n = 0; n < 2; ++n) { gv[bj][n] = (f32x4){1.f, 1.f, 1.f, 1.f};
                if (t < 2) gv[bj][n] = *(const f32x4*)((t == 0 ? gq : gk) + 32 * bj + 8 * fq + 4 * n) * (t == 0 ? qscale : 1.0f); }
#pragma unroll
        for (int ai = 0; ai < 2; ++ai)
#pragma unroll
            for (int m = 0; m < 4; ++m) { const int row = row0 + ai * HALF + m * 16; const float rs = rstd_row(ssq, row);
                f32x4 v[2][2]; float ss = 0.f;
#pragma unroll
                for (int bj = 0; bj < 2; ++bj)
#pragma unroll
                    for (int n = 0; n < 2; ++n) { v[bj][n] = acc[ai][bj][m][n] * rs; const f32x4 q = v[bj][n] * v[bj][n]; ss += (q[0] + q[1]) + (q[2] + q[3]); }
                if (t < 2) { ss += __shfl_xor(ss, 16); ss += __shfl_xor(ss, 32); const float rn = rsqrtf(ss * (1.0f / (float)HD) + RMS_EPS);
#pragma unroll
                    for (int bj = 0; bj < 2; ++bj)
#pragma unroll
                        for (int n = 0; n < 2; ++n) v[bj][n] = v[bj][n] * rn * gv[bj][n]; }
                if (t == 3) {
#pragma unroll
                    for (int bj = 0; bj < 2; ++bj)
#pragma unroll
                        for (int n = 0; n < 2; ++n)
#pragma unroll
                            for (int e = 0; e < 4; ++e) v[bj][n][e] = sigmoid_f(v[bj][n][e]); }
#pragma unroll
                for (int bj = 0; bj < 2; ++bj) { u32x4 w; w.x = cvt_pk_bf16(v[bj][0][0], v[bj][0][1]); w.y = cvt_pk_bf16(v[bj][0][2], v[bj][0][3]); w.z = cvt_pk_bf16(v[bj][1][0], v[bj][1][1]); w.w = cvt_pk_bf16(v[bj][1][2], v[bj][1][3]);
                    *(u32x4*)(base + (size_t)row * DM + 32 * bj) = w; } }
    }
};

struct EpiSwiglu {
    static constexpr bool PERM = true;
    bf16_t* O; const ssq_t* ssq;
    __device__ __forceinline__ void operator()(const f32x4 (&acc)[2][2][4][2], const Unit& u, int wr, int wc, int fr, int fq) const {
        const int row0 = u.pm * BM + wr * 64 + fr, col0 = u.pn * HALF + wc * 32 + 8 * fq;
#pragma unroll
        for (int ai = 0; ai < 2; ++ai)
#pragma unroll
            for (int m = 0; m < 4; ++m) { const int row = row0 + ai * HALF + m * 16; const float rs = rstd_row(ssq, row); f32x4 a[2];
#pragma unroll
                for (int n = 0; n < 2; ++n) { const f32x4 g = acc[ai][0][m][n] * rs, up = acc[ai][1][m][n] * rs;
#pragma unroll
                    for (int e = 0; e < 4; ++e) a[n][e] = g[e] * sigmoid_f(g[e]) * up[e]; }
                u32x4 w; w.x = cvt_pk_bf16(a[0][0], a[0][1]); w.y = cvt_pk_bf16(a[0][2], a[0][3]); w.z = cvt_pk_bf16(a[1][0], a[1][1]); w.w = cvt_pk_bf16(a[1][2], a[1][3]);
                *(u32x4*)(O + (size_t)row * FF + col0) = w; }
    }
};

template <bool HAS_SCALE, bool OUT_F32> struct EpiResid {
    static constexpr bool PERM = true;
    bf16_t* hb; float* outf; ssq_t* ssq_out; const float* colscale;
    __device__ __forceinline__ void operator()(f32x4 (&acc)[2][2][4][2], const Unit& u, int wr, int wc, int fr, int fq) const {
        const int row0 = u.pm * BM + wr * 64 + fr, col0 = u.pn * BM + wc * 32 + 8 * fq;
        if constexpr (HAS_SCALE) {
#pragma unroll
            for (int bj = 0; bj < 2; ++bj)
#pragma unroll
                for (int n = 0; n < 2; ++n) { const f32x4 sc = *(const f32x4*)(colscale + col0 + bj * HALF + 4 * n);
#pragma unroll
                    for (int ai = 0; ai < 2; ++ai)
#pragma unroll
                        for (int m = 0; m < 4; ++m) acc[ai][bj][m][n] = acc[ai][bj][m][n] * sc; }
        }
        u32x4 b[2][2];
#define ER_LOAD(g) _Pragma("unroll") for (int mm = 0; mm < 2; ++mm) _Pragma("unroll") for (int bj = 0; bj < 2; ++bj) b[mm][bj] = *(const u32x4*)(hb + (size_t)(row0 + ((g) >> 1) * HALF + (2 * ((g) & 1) + mm) * 16) * DM + col0 + bj * HALF);
#define ER_COMP(g) _Pragma("unroll") for (int mm = 0; mm < 2; ++mm) _Pragma("unroll") for (int bj = 0; bj < 2; ++bj) { const u32x4 w = b[mm][bj]; \
            acc[(g) >> 1][bj][2 * ((g) & 1) + mm][0] += (f32x4){__uint_as_float(w.x << 16), __uint_as_float(w.x & 0xffff0000u), __uint_as_float(w.y << 16), __uint_as_float(w.y & 0xffff0000u)}; \
            acc[(g) >> 1][bj][2 * ((g) & 1) + mm][1] += (f32x4){__uint_as_float(w.z << 16), __uint_as_float(w.z & 0xffff0000u), __uint_as_float(w.w << 16), __uint_as_float(w.w & 0xffff0000u)}; }
#define ER_STORE(g) _Pragma("unroll") for (int mm = 0; mm < 2; ++mm) { const int ai = (g) >> 1, m = 2 * ((g) & 1) + mm; const int row = row0 + ai * HALF + m * 16; const size_t off = (size_t)row * DM + col0; float ss = 0.f; \
            _Pragma("unroll") for (int bj = 0; bj < 2; ++bj) { const f32x4 o0 = acc[ai][bj][m][0], o1 = acc[ai][bj][m][1]; \
                const f32x4 q0 = o0 * o0, q1 = o1 * o1; ss += ((q0[0] + q0[1]) + (q0[2] + q0[3])) + ((q1[0] + q1[1]) + (q1[2] + q1[3])); \
                if constexpr (OUT_F32) { *(f32x4*)(outf + off + bj * HALF) = o0; *(f32x4*)(outf + off + bj * HALF + 4) = o1; } \
                else { u32x4 v; v.x = cvt_pk_bf16(o0[0], o0[1]); v.y = cvt_pk_bf16(o0[2], o0[3]); v.z = cvt_pk_bf16(o1[0], o1[1]); v.w = cvt_pk_bf16(o1[2], o1[3]); *(u32x4*)(hb + off + bj * HALF) = v; } } \
            ss += __shfl_xor(ss, 16); ss += __shfl_xor(ss, 32); \
            if (fq == 0) (void)__hip_atomic_fetch_add(ssq_out + row, (ssq_t)(ss * SSQ_SCALE), __ATOMIC_RELAXED, __HIP_MEMORY_SCOPE_AGENT); }
#define ER_FENCE asm volatile("" ::: "memory");
        ER_LOAD(0) ER_FENCE ER_COMP(0) ER_FENCE
        ER_LOAD(1) ER_FENCE ER_STORE(0) ER_FENCE ER_COMP(1) ER_FENCE
        ER_LOAD(2) ER_FENCE ER_STORE(1) ER_FENCE ER_COMP(2) ER_FENCE
        ER_LOAD(3) ER_FENCE ER_STORE(2) ER_FENCE ER_COMP(3) ER_FENCE
        ER_STORE(3)
#undef ER_LOAD
#undef ER_COMP
#undef ER_STORE
#undef ER_FENCE
    }
};

template <class Epi>
__device__ __forceinline__ void gemm_phase(PG8_LAS unsigned char* lds, const Gemm g, const StaticOrder& S, const Epi& E, const int tid) {
    const int wid = __builtin_amdgcn_readfirstlane(tid >> 6), lane = tid & 63, wr = wid >> 2, wc = wid & 3, fr = lane & 15, fq = lane >> 4;
    const int K = g.K, nt = K / BK, lda = g.lda;
    unsigned voffA[2], voffB[2];
#pragma unroll
    for (int i = 0; i < 2; ++i) { int R, C; stage_rc(tid * 16 + i * 8192, R, C); const int Rb = Epi::PERM ? ((R & ~31) + perm32(R & 31)) : R;
        voffA[i] = (unsigned)(R * lda + C) * 2u; voffB[i] = (unsigned)(Rb * K + C) * 2u; }
    const size_t kstep = (size_t)(BK * 2);
    const size_t hsA = (size_t)HALF * lda * 2, hsB = (size_t)HALF * K * 2;
    const size_t tsA = 2 * hsA, tsB = 2 * hsB;
    const size_t gsA = (size_t)K * 2;
    const unsigned ldsw = (unsigned)wid * 1024u;
    const int aoff = lds_byte(wr * 64 + fr, fq * 8), boff = lds_byte(wc * 32 + fr, fq * 8);
#define PG8_UA(u) ((const char*)g.A + (size_t)(u).pm * tsA + (size_t)((u).pn / g.gdiv) * gsA)
#define PG8_UB(u) ((const char*)g.Bt + (size_t)(u).pn * tsB)
#define PG8_SA(b, h) (((b) * 2 + (h)) * HTB)
#define PG8_SB(b, h) ((4 + (b) * 2 + (h)) * HTB)
#define PG8_STAGE(bufoff, gbase, voff) do { _Pragma("unroll") for (int _i = 0; _i < 2; ++_i) \
        __builtin_amdgcn_global_load_lds((const unsigned*)((const char*)(gbase) + (voff)[_i]), (PG8_LAS unsigned*)(lds + (bufoff) + ldsw + _i * 8192), 16, 0, 0); } while (0)
#define PG8_LDA(dst, b, h) do { _Pragma("unroll") for (int m = 0; m < 4; ++m) _Pragma("unroll") for (int k = 0; k < 2; ++k) dst[m][k] = *(const PG8_LAS bf16x8*)(lds + PG8_SA(b, h) + aoff + m * 2048 + k * 1024); } while (0)
#define PG8_LDB(dst, b, h) do { _Pragma("unroll") for (int n = 0; n < 2; ++n) _Pragma("unroll") for (int k = 0; k < 2; ++k) dst[n][k] = *(const PG8_LAS bf16x8*)(lds + PG8_SB(b, h) + boff + n * 2048 + k * 1024); } while (0)
#define PG8_MMA(ai, bj, At, Bt) do { __builtin_amdgcn_s_setprio(1); _Pragma("unroll") for (int m = 0; m < 4; ++m) _Pragma("unroll") for (int n = 0; n < 2; ++n) _Pragma("unroll") for (int k = 0; k < 2; ++k) \
        acc[ai][bj][m][n] = __builtin_amdgcn_mfma_f32_16x16x32_bf16(Bt[n][k], At[m][k], acc[ai][bj][m][n], 0, 0, 0); __builtin_amdgcn_s_setprio(0); } while (0)
#define PG8_WAIT_V(n) asm volatile("s_waitcnt vmcnt(" #n ")" ::: "memory")
#define PG8_WAIT_L(n) asm volatile("s_waitcnt lgkmcnt(" #n ")" ::: "memory")
#define PG8_BAR __builtin_amdgcn_s_barrier()
#define PG8_SCHED __builtin_amdgcn_sched_barrier(0)
    Unit cur, nxt; int ui = 0;
    if (!S.next(0, cur)) return;
    f32x4 acc[2][2][4][2];
#pragma unroll
    for (int a = 0; a < 2; ++a)
#pragma unroll
        for (int b = 0; b < 2; ++b)
#pragma unroll
            for (int m = 0; m < 4; ++m)
#pragma unroll
                for (int n = 0; n < 2; ++n) acc[a][b][m][n] = (f32x4){0.f, 0.f, 0.f, 0.f};
    bf16x8 At[4][2], B0[2][2], B1[2][2];
    const char* cA = PG8_UA(cur); const char* cB = PG8_UB(cur);
    PG8_STAGE(PG8_SB(0, 0), cB, voffB); PG8_STAGE(PG8_SB(0, 1), cB + hsB, voffB); PG8_STAGE(PG8_SA(0, 0), cA, voffA); PG8_STAGE(PG8_SA(0, 1), cA + hsA, voffA);
    if (wr == 1) PG8_BAR;
    PG8_WAIT_V(2); PG8_BAR;
    PG8_STAGE(PG8_SB(1, 0), cB + kstep, voffB); PG8_STAGE(PG8_SA(1, 0), cA + kstep, voffA); PG8_STAGE(PG8_SB(1, 1), cB + hsB + kstep, voffB);
    PG8_WAIT_V(6); PG8_BAR;
    for (;;) {
        const bool has_next = S.next(ui + 1, nxt);
        const char* nA = has_next ? PG8_UA(nxt) : cA; const char* nB = has_next ? PG8_UB(nxt) : cB;
        for (int t = 0; t < nt; t += 2) {
            const bool last = (t == nt - 2);
            const char* a1 = cA + (size_t)(t + 1) * kstep;
            const char* a2 = last ? nA : cA + (size_t)(t + 2) * kstep; const char* b2 = last ? nB : cB + (size_t)(t + 2) * kstep;
            const char* a3 = a2 + kstep; const char* b3 = b2 + kstep;
            PG8_LDB(B0, 0, 0); PG8_LDB(B1, 0, 1); PG8_SCHED; PG8_LDA(At, 0, 0); PG8_STAGE(PG8_SA(1, 1), a1 + hsA, voffA);
            PG8_WAIT_V(8); PG8_WAIT_L(0); PG8_BAR; PG8_MMA(0, 0, At, B0); PG8_MMA(0, 1, At, B1); PG8_BAR; PG8_SCHED;
            PG8_LDA(At, 0, 1); PG8_STAGE(PG8_SB(0, 0), b2, voffB); PG8_STAGE(PG8_SB(0, 1), b2 + hsB, voffB); PG8_STAGE(PG8_SA(0, 0), a2, voffA);
            PG8_WAIT_V(8); PG8_WAIT_L(0); PG8_BAR; PG8_MMA(1, 0, At, B0); PG8_MMA(1, 1, At, B1); PG8_BAR; PG8_SCHED;
            PG8_LDB(B0, 1, 0); PG8_LDB(B1, 1, 1); PG8_SCHED; PG8_LDA(At, 1, 0); PG8_STAGE(PG8_SA(0, 1), a2 + hsA, voffA);
            PG8_WAIT_V(8); PG8_WAIT_L(0); PG8_BAR; PG8_MMA(0, 0, At, B0); PG8_MMA(0, 1, At, B1); PG8_BAR; PG8_SCHED;
            PG8_LDA(At, 1, 1); PG8_STAGE(PG8_SB(1, 0), b3, voffB); PG8_STAGE(PG8_SB(1, 1), b3 + hsB, voffB); PG8_STAGE(PG8_SA(1, 0), a3, voffA);
            PG8_WAIT_V(8); PG8_WAIT_L(0); PG8_BAR; PG8_MMA(1, 0, At, B0); PG8_MMA(1, 1, At, B1); PG8_BAR; PG8_SCHED;
        }
        if (wr == 0) PG8_BAR;
        { int fr2 = fr, fq2 = fq; asm volatile("" : "+v"(fr2), "+v"(fq2)); E(acc, cur, wr, wc, fr2, fq2); }
        if (!has_next) break;
#pragma unroll
        for (int a = 0; a < 2; ++a)
#pragma unroll
            for (int b = 0; b < 2; ++b)
#pragma unroll
                for (int m = 0; m < 4; ++m)
#pragma unroll
                    for (int n = 0; n < 2; ++n) acc[a][b][m][n] = (f32x4){0.f, 0.f, 0.f, 0.f};
        cur = nxt; cA = nA; cB = nB; ++ui;
        if (wr == 1) PG8_BAR;
    }
    PG8_WAIT_V(0);
    PG8_BAR;
#undef PG8_UA
#undef PG8_UB
#undef PG8_SA
#undef PG8_SB
#undef PG8_STAGE
#undef PG8_LDA
#undef PG8_LDB
#undef PG8_MMA
#undef PG8_WAIT_V
#undef PG8_WAIT_L
#undef PG8_BAR
#undef PG8_SCHED
}
}

#include <hip/hip_bf16.h>
#include <cmath>
namespace attn_body {
using bf16=__hip_bfloat16;
using bf16x8=__attribute__((ext_vector_type(8)))short;
using s16x4=__attribute__((ext_vector_type(4)))short;
using f32x16=__attribute__((ext_vector_type(16)))float;
using u32x4=__attribute__((ext_vector_type(4)))unsigned;
using f32x4v=__attribute__((ext_vector_type(4)))float;
constexpr int BATCH=4,NHEAD=32,SEQ=4096,D=64,DM=NHEAD*D;
constexpr int NW=8,QBLK=32,QB=QBLK*NW,KVBLK=64,NQB=SEQ/QB;
constexpr int ATTN_PITCH=DM, ATTN_UNIT_ROWS=QB;
__device__ __forceinline__ int crow(int r,int hi){return (r&3)+8*(r>>2)+4*hi;}
#define SBAR() __builtin_amdgcn_sched_barrier(0)
__device__ __forceinline__ void cmask(f32x16&p0,f32x16&p1,int jb,int qrel,int hi){
  const float NEG=-INFINITY; int kb=64*jb+4*hi;
  #pragma unroll
  for(int r=0;r<16;++r){int kv=kb+(r&3)+8*(r>>2); if(kv>qrel)p0[r]=NEG; if(kv+32>qrel)p1[r]=NEG;}
}

constexpr int NSLOT=3, SLOTB=8192;
constexpr int LDS_K=0, LDS_V=NSLOT*SLOTB, LDS_WS=2*NSLOT*SLOTB, LDS_OST=LDS_WS+NW*64*4, LDS_NB=LDS_OST+NW*4096, LDS_WT=LDS_NB+SEQ*4, LDS_BYTES=LDS_WT+64;
constexpr float C2=0.125f*1.4426950408889634f;
__device__ __forceinline__ void glds16(const void*gsrc,unsigned lds_dst){unsigned keep;
  asm volatile("s_mov_b32 %0, m0\n\ts_mov_b32 m0, %2\n\ts_nop 0\n\tglobal_load_lds_dwordx4 %1, off\n\ts_mov_b32 m0, %0":"=&s"(keep):"v"(gsrc),"s"(lds_dst):"memory");}
__device__ __forceinline__ float max3f(float a,float b,float c){float r;asm("v_max3_f32 %0, %1, %2, %3":"=v"(r):"v"(a),"v"(b),"v"(c));return r;}
__device__ __forceinline__ float max2f(float a,float b){float r;asm("v_max_f32_e32 %0, %1, %2":"=v"(r):"v"(a),"v"(b));return r;}
__device__ __forceinline__ float fadd_s(float a,float b){float r;asm("v_add_f32_e32 %0, %1, %2":"=v"(r):"v"(a),"v"(b));return r;}
__device__ __forceinline__ float fsub_s(float a,float b){float r;asm("v_sub_f32_e32 %0, %1, %2":"=v"(r):"v"(a),"v"(b));return r;}
typedef float f32x2_t __attribute__((ext_vector_type(2))); typedef __bf16 bf16x2_t __attribute__((ext_vector_type(2)));
__device__ __forceinline__ unsigned cvtpk_s(float lo,float hi){f32x2_t v={lo,hi};bf16x2_t b=__builtin_convertvector(v,bf16x2_t);return __builtin_bit_cast(unsigned,b);}
#define WAIT_BAR(N) asm volatile("s_waitcnt vmcnt(" #N ") lgkmcnt(0)\n\ts_barrier":::"memory")

__device__ __forceinline__ void qkt(f32x16&p0,f32x16&p1,const char*Kslot,const bf16x8*qr,int r32,int hi){
  const char*kb=Kslot+hi*1024+r32*16;
  #pragma unroll
  for(int d0=0;d0<4;++d0){
    const bf16x8 b0=*reinterpret_cast<const bf16x8*>(kb+d0*2048);
    const bf16x8 b1=*reinterpret_cast<const bf16x8*>(kb+d0*2048+512);
    p0=__builtin_amdgcn_mfma_f32_32x32x16_bf16(b0,qr[d0],p0,0,0,0);p1=__builtin_amdgcn_mfma_f32_32x32x16_bf16(b1,qr[d0],p1,0,0,0);}
}
typedef __attribute__((address_space(3))) const char* lds_cptr;
typedef short v4i16_t __attribute__((ext_vector_type(4)));
__device__ __forceinline__ void kload8(bf16x8*kf,lds_cptr kp){
  kf[0]=*(const __attribute__((address_space(3))) bf16x8*)(kp);      kf[1]=*(const __attribute__((address_space(3))) bf16x8*)(kp+512);
  kf[2]=*(const __attribute__((address_space(3))) bf16x8*)(kp+2048); kf[3]=*(const __attribute__((address_space(3))) bf16x8*)(kp+2560);
  kf[4]=*(const __attribute__((address_space(3))) bf16x8*)(kp+4096); kf[5]=*(const __attribute__((address_space(3))) bf16x8*)(kp+4608);
  kf[6]=*(const __attribute__((address_space(3))) bf16x8*)(kp+6144); kf[7]=*(const __attribute__((address_space(3))) bf16x8*)(kp+6656);
}
__device__ __forceinline__ void kload2(bf16x8*kf,lds_cptr kp,int j){ kf[2*j]=*(const __attribute__((address_space(3))) bf16x8*)(kp+j*2048); kf[2*j+1]=*(const __attribute__((address_space(3))) bf16x8*)(kp+j*2048+512); }
__device__ __forceinline__ s16x4 vtr(lds_cptr p){ return __builtin_bit_cast(s16x4,__builtin_amdgcn_ds_read_tr16_b64_v4i16((__attribute__((address_space(3))) v4i16_t*)p)); }
__device__ __forceinline__ float rowmax(const f32x16&p0,const f32x16&p1){
  float a=max3f(p0[0],p0[1],p1[0]),b=max3f(p0[2],p0[3],p1[1]);a=max3f(a,p1[2],p1[3]);
  #pragma unroll
  for(int r=4;r<16;r+=4){a=max3f(a,p0[r],p0[r+1]);b=max3f(b,p0[r+2],p0[r+3]);a=max3f(a,p1[r],p1[r+1]);b=max3f(b,p1[r+2],p1[r+3]);}
  const float m=max2f(a,b);
  auto rr=__builtin_amdgcn_permlane32_swap(__float_as_uint(m),__float_as_uint(m),false,false);
  return max2f(__uint_as_float(rr[0]),__uint_as_float(rr[1]));
}
__device__ __forceinline__ void pv(f32x16*o,int vb,bf16x8 pa0,bf16x8 pa1,bf16x8 pa2,bf16x8 pa3){
  #pragma unroll
  for(int d0=0;d0<2;++d0){s16x4 lo[4],hi[4];
    #pragma unroll
    for(int ks=0;ks<4;++ks){
      asm volatile("ds_read_b64_tr_b16 %0,%1 offset:%c2":"=&v"(lo[ks]):"v"(vb),"i"(d0*4096+ks*1024):"memory");
      asm volatile("ds_read_b64_tr_b16 %0,%1 offset:%c2":"=&v"(hi[ks]):"v"(vb),"i"(d0*4096+ks*1024+512):"memory");}
    asm volatile("s_waitcnt lgkmcnt(0)":::"memory");SBAR();
    #define PK(k) (bf16x8){lo[k][0],lo[k][1],lo[k][2],lo[k][3],hi[k][0],hi[k][1],hi[k][2],hi[k][3]}
    o[d0]=__builtin_amdgcn_mfma_f32_32x32x16_bf16(pa0,PK(0),o[d0],0,0,0);
    o[d0]=__builtin_amdgcn_mfma_f32_32x32x16_bf16(pa1,PK(1),o[d0],0,0,0);
    o[d0]=__builtin_amdgcn_mfma_f32_32x32x16_bf16(pa2,PK(2),o[d0],0,0,0);
    o[d0]=__builtin_amdgcn_mfma_f32_32x32x16_bf16(pa3,PK(3),o[d0],0,0,0);
    #undef PK
  }
}

#ifndef ATTN_STORE16
#define ATTN_STORE16(p,v) (*(u32x4*)(p)=(v))
#endif
template<int THRL> __device__ __forceinline__ void attn_unit(int b,int h,int qb,int ts,const bf16*Q,const bf16*__restrict__ K,const bf16*__restrict__ V,bf16*O,const bf16*__restrict__ SG,char*shm,const int tid){
  const int lane=tid&63,r32=lane&31,hi=lane>>5; const int wid=__builtin_amdgcn_readfirstlane(tid>>6);
  const long rowbase=(long)b*SEQ; const int q0=qb*QB;
  const bf16*Qw=Q+(rowbase+q0+wid*QBLK)*DM+h*D;
  const bf16*Kh=K+(rowbase+(long)ts*KVBLK)*DM+h*D,*Vh=V+(rowbase+(long)ts*KVBLK)*DM+h*D;
  const lds_cptr shm3=(lds_cptr)shm;
  const unsigned lds0=(unsigned)(uintptr_t)shm;
  float*wsf=(float*)(shm+LDS_WS)+wid*64;
  const bf16*ksrc=Kh+(long)lane*DM+wid*8;
  const bf16*vsrc=Vh+(long)(16*(wid&3)+(lane>>2))*DM+(wid>>2)*32+(lane&3)*8;
  const unsigned kdst=lds0+LDS_K+wid*1024, vdst=lds0+LDS_V+wid*1024;
  #define DMA_K(t,slot) glds16(ksrc+(long)(t)*KVBLK*DM,(unsigned)__builtin_amdgcn_readfirstlane(kdst+(slot)))
  #define DMA_V(t,slot) glds16(vsrc+(long)(t)*KVBLK*DM,(unsigned)__builtin_amdgcn_readfirstlane(vdst+(slot)))
  const int vb0=(int)(lds0+LDS_V)+((lane>>4)&1)*32+(lane&3)*8+(4*hi+((lane&15)>>2))*64;
  const char*Kbase=shm+LDS_K; bf16x8 kf[8];
  const lds_cptr kp0=shm3+LDS_K+hi*1024+r32*16; const lds_cptr vp0=shm3+LDS_V+((lane>>4)&1)*32+(lane&3)*8+(4*hi+((lane&15)>>2))*64;
  const int NT=(q0+QB)/KVBLK-ts;
  DMA_K(0,0);DMA_V(0,0);DMA_K(1,SLOTB);
  bf16x8 qr[4];
  #pragma unroll
  for(int d0=0;d0<4;++d0)qr[d0]=*reinterpret_cast<const bf16x8*>(&Qw[(long)r32*DM+d0*16+hi*8]);
  float l_reg=0.f;f32x16 o[2];o[0]=f32x16{};o[1]=f32x16{};
  const int qrel=wid*QBLK+r32;
  typedef __attribute__((address_space(3))) const f32x4v* nb_ptr; const nb_ptr nbp0=(nb_ptr)(shm3+LDS_NB)+hi+ts*16;
  float negs=-((const __attribute__((address_space(3))) float*)(shm3+LDS_NB))[q0+qrel];
  #define CINIT(C0,C1,t) do{ const nb_ptr bp_=nbp0+(t)*16; _Pragma("unroll") for(int j_=0;j_<4;++j_){ const f32x4v a_=bp_[2*j_], b_=bp_[8+2*j_]; \
      C0[4*j_]=a_[0]+negs; C0[4*j_+1]=a_[1]+negs; C0[4*j_+2]=a_[2]+negs; C0[4*j_+3]=a_[3]+negs; \
      C1[4*j_]=b_[0]+negs; C1[4*j_+1]=b_[1]+negs; C1[4*j_+2]=b_[2]+negs; C1[4*j_+3]=b_[3]+negs; } }while(0)
  #define CMASK(P0,P1,t) do{int jb_=(t)-(NT-4); if(jb_>=0)cmask(P0,P1,jb_,qrel,hi);}while(0)
  bool resc=false;
  #define START(P0,P1) do{ const float rm=rowmax(P0,P1); resc=false; \
    if(__any(rm>(float)THRL)){ const float dl=__builtin_fmaxf(rm,0.f); negs-=dl; \
      _Pragma("unroll") for(int r=0;r<16;++r){P0[r]-=dl;P1[r]-=dl;} } \
    _Pragma("unroll") for(int r=0;r<16;++r)P0[r]=__builtin_amdgcn_exp2f(P0[r]); }while(0)
  #define RESC() do{ if(resc){ asm volatile("s_waitcnt lgkmcnt(0)":::"memory"); \
      _Pragma("unroll") for(int d_=0;d_<2;++d_) _Pragma("unroll") for(int r=0;r<16;++r)o[d_][r]*=wsf[crow(r,hi)]; } }while(0)
  f32x16 pA0,pA1,pB0,pB1;
  int sl_prev=0,sl_cur=0,sl_next=SLOTB;
  #define ROT() do{sl_prev=sl_cur;sl_cur=sl_next;sl_next=(sl_next==(NSLOT-1)*SLOTB)?0:sl_next+SLOTB;}while(0)
  DMA_K(2,2*SLOTB);
  WAIT_BAR(3);
  CINIT(pA0,pA1,0); qkt(pA0,pA1,Kbase,qr,r32,hi);asm volatile("s_nop 15\n\ts_nop 7":"+v"(pA0),"+v"(pA1));CMASK(pA0,pA1,0);
  START(pA0,pA1);
  _Pragma("unroll") for(int r=0;r<16;++r)pA1[r]=__builtin_amdgcn_exp2f(pA1[r]);
  WAIT_BAR(0);
  DMA_K(3,0);DMA_V(1,SLOTB);
  ROT();
  kload8(kf,kp0+sl_cur);
  WAIT_BAR(2);
  s16x4 vlo[8],vhi[8]; u32x4 pw0,pw1,pw2,pw3;
  #define PKW(P,B) cvtpk_s(P[B],P[B+1])
  #define PAF(k) __builtin_bit_cast(bf16x8,pw##k)
  #define VFR(i) (bf16x8){vlo[i][0],vlo[i][1],vlo[i][2],vlo[i][3],vhi[i][0],vhi[i][1],vhi[i][2],vhi[i][3]}
  #define PIN(x) asm volatile("":"+v"(x))
  #define MX3(a,b,c) __builtin_fmaxf(__builtin_fmaxf((a),(b)),(c))
  #define GAPA(MF,A0,A1,A2,A3,W0,W1,PW) do{ MF; sacc+=A0; sacc+=A1; sacc+=A2; sacc+=A3; PIN(sacc); W0; W1; PIN(PW); SBAR(); }while(0)
  #define EX(v) __builtin_amdgcn_exp2f(v)
  #define GAPB(MF,X,B) do{ MF; X[B]=EX(X[B]); X[B+1]=EX(X[B+1]); X[B+2]=EX(X[B+2]); X[B+3]=EX(X[B+3]); PIN(X); SBAR(); }while(0)
  #define VRD(i) do{ vlo[i]=vtr(vp_+(((i)>>2)*4096+((i)&3)*1024)); vhi[i]=vtr(vp_+(((i)>>2)*4096+((i)&3)*1024+512)); }while(0)
  #define KRD(G,j) do{ if(G){ kload2(kf,kp0+sl_next,j); SBAR(); } }while(0)
  #define STEP(C0,C1,P0,P1,t,GK,GV,GL) do{ SBAR(); CINIT(C0,C1,t); SBAR(); \
    const lds_cptr vp_=vp0+sl_prev; \
    VRD(0); SBAR(); float sacc=(P0[0]+P0[1]); \
    GAPA(C0=__builtin_amdgcn_mfma_f32_32x32x16_bf16(kf[0],qr[0],C0,0,0,0), P0[2],P0[3],P0[4],P0[5],     pw0[0]=PKW(P0,0), pw0[1]=PKW(P0,2), pw0); \
    VRD(4); SBAR(); GAPA(C1=__builtin_amdgcn_mfma_f32_32x32x16_bf16(kf[1],qr[0],C1,0,0,0), P0[6],P0[7],P0[8],P0[9],     pw0[2]=PKW(P0,4), pw0[3]=PKW(P0,6), pw0); \
    VRD(1); SBAR(); GAPA(C0=__builtin_amdgcn_mfma_f32_32x32x16_bf16(kf[2],qr[1],C0,0,0,0),   P0[10],P0[11],P0[12],P0[13], pw1[0]=PKW(P0,8), pw1[1]=PKW(P0,10), pw1); \
    VRD(5); SBAR(); GAPA(C1=__builtin_amdgcn_mfma_f32_32x32x16_bf16(kf[3],qr[1],C1,0,0,0),   P0[14],P0[15],P1[0],P1[1],   pw1[2]=PKW(P0,12),pw1[3]=PKW(P0,14), pw1); \
    VRD(2); SBAR(); GAPA(C0=__builtin_amdgcn_mfma_f32_32x32x16_bf16(kf[4],qr[2],C0,0,0,0),   P1[2],P1[3],P1[4],P1[5],     pw2[0]=PKW(P1,0), pw2[1]=PKW(P1,2), pw2); \
    VRD(6); SBAR(); GAPA(C1=__builtin_amdgcn_mfma_f32_32x32x16_bf16(kf[5],qr[2],C1,0,0,0),   P1[6],P1[7],P1[8],P1[9],     pw2[2]=PKW(P1,4), pw2[3]=PKW(P1,6), pw2); \
    VRD(3); SBAR(); GAPA(C0=__builtin_amdgcn_mfma_f32_32x32x16_bf16(kf[6],qr[3],C0,0,0,0),   P1[10],P1[11],P1[12],P1[13], pw3[0]=PKW(P1,8), pw3[1]=PKW(P1,10), pw3); \
    VRD(7); SBAR(); GAPA(C1=__builtin_amdgcn_mfma_f32_32x32x16_bf16(kf[7],qr[3],C1,0,0,0),   P1[14],P1[15],0.f,0.f,       pw3[2]=PKW(P1,12),pw3[3]=PKW(P1,14), pw3); \
    l_reg+=sacc; \
    if(GK){DMA_K((t)+3,sl_cur);} if(GV){DMA_V((t)+1,sl_next);} \
    CMASK(C0,C1,t); \
    { float a=MX3(C0[0],C0[1],C1[0]),b=MX3(C0[2],C0[3],C1[1]); a=MX3(a,C1[2],C1[3]); \
      _Pragma("unroll") for(int r=4;r<16;r+=4){a=MX3(a,C0[r],C0[r+1]);b=MX3(b,C0[r+2],C0[r+3]);a=MX3(a,C1[r],C1[r+1]);b=MX3(b,C1[r+2],C1[r+3]);} \
      float rm=__builtin_fmaxf(a,b); { auto rr=__builtin_amdgcn_permlane32_swap(__float_as_uint(rm),__float_as_uint(rm),false,false); rm=__builtin_fmaxf(__uint_as_float(rr[0]),__uint_as_float(rr[1])); } \
      resc=false; \
      if(__builtin_expect(__any(rm>(float)THRL),0)){ const float dl=__builtin_fmaxf(rm,0.f); \
        _Pragma("unroll") for(int r=0;r<16;++r){C0[r]-=dl;C1[r]-=dl;} \
        negs-=dl; \
        const float f=__builtin_amdgcn_exp2f(-dl); l_reg*=f; if(hi==0)wsf[r32]=f; resc=true; } } \
    SBAR(); \
    GAPB(o[0]=__builtin_amdgcn_mfma_f32_32x32x16_bf16(PAF(0),VFR(0),o[0],0,0,0), C0,0); \
    GAPB(o[1]=__builtin_amdgcn_mfma_f32_32x32x16_bf16(PAF(0),VFR(4),o[1],0,0,0), C0,4); \
    KRD(GL,0); GAPB(o[0]=__builtin_amdgcn_mfma_f32_32x32x16_bf16(PAF(1),VFR(1),o[0],0,0,0), C0,8); \
    KRD(GL,1); GAPB(o[1]=__builtin_amdgcn_mfma_f32_32x32x16_bf16(PAF(1),VFR(5),o[1],0,0,0), C0,12); \
    KRD(GL,2); GAPB(o[0]=__builtin_amdgcn_mfma_f32_32x32x16_bf16(PAF(2),VFR(2),o[0],0,0,0), C1,0); \
    KRD(GL,3); GAPB(o[1]=__builtin_amdgcn_mfma_f32_32x32x16_bf16(PAF(2),VFR(6),o[1],0,0,0), C1,4); \
    GAPB(o[0]=__builtin_amdgcn_mfma_f32_32x32x16_bf16(PAF(3),VFR(3),o[0],0,0,0), C1,8); \
    GAPB(o[1]=__builtin_amdgcn_mfma_f32_32x32x16_bf16(PAF(3),VFR(7),o[1],0,0,0), C1,12); \
    }while(0)
  int t=1;
  #undef CMASK
  #define CMASK(P0,P1,t) do{}while(0)
  for(;t+5<NT;t+=2){
    STEP(pB0,pB1,pA0,pA1,t,true,true,true);     WAIT_BAR(2); RESC(); ROT();
    STEP(pA0,pA1,pB0,pB1,t+1,true,true,true);   WAIT_BAR(2); RESC(); ROT();
  }
  #undef CMASK
  #define CMASK(P0,P1,t) do{int jb_=(t)-(NT-4); if(jb_>=0)cmask(P0,P1,jb_,qrel,hi);}while(0)
  #define ENDW(tt) do{ if((tt)+3<NT){WAIT_BAR(2);} else if((tt)+2<NT){WAIT_BAR(1);} else {WAIT_BAR(0);} }while(0)
  for(;t+1<NT;t+=2){
    STEP(pB0,pB1,pA0,pA1,t,(t+3<NT),(t+1<NT),(t+1<NT));       ENDW(t);   RESC(); ROT();
    STEP(pA0,pA1,pB0,pB1,t+1,(t+4<NT),(t+2<NT),(t+2<NT));     ENDW(t+1); RESC(); ROT();
  }
  STEP(pB0,pB1,pA0,pA1,NT-1,false,false,false); RESC();
  { float sacc=pB0[0]+pB0[1]; _Pragma("unroll") for(int r=2;r<16;++r)sacc+=pB0[r]; _Pragma("unroll") for(int r=0;r<16;++r)sacc+=pB1[r]; l_reg+=sacc;
    pw0=(u32x4){PKW(pB0,0),PKW(pB0,2),PKW(pB0,4),PKW(pB0,6)};pw1=(u32x4){PKW(pB0,8),PKW(pB0,10),PKW(pB0,12),PKW(pB0,14)};pw2=(u32x4){PKW(pB1,0),PKW(pB1,2),PKW(pB1,4),PKW(pB1,6)};pw3=(u32x4){PKW(pB1,8),PKW(pB1,10),PKW(pB1,12),PKW(pB1,14)};
    SBAR(); pv(o,vb0+sl_cur,PAF(0),PAF(1),PAF(2),PAF(3)); }
  #undef PKW
  #undef PAF
  #undef VFR
  #undef PIN
  #undef MX3
  #undef GAPA
  #undef GAPB
  #undef EX
  #undef VRD
  #undef KRD
  #undef STEP
  #undef ENDW
  {auto rr=__builtin_amdgcn_permlane32_swap(__float_as_uint(l_reg),__float_as_uint(l_reg),false,false);l_reg=__uint_as_float(rr[0])+__uint_as_float(rr[1]);}
  if(hi==0)wsf[32+r32]=l_reg;asm volatile("s_waitcnt lgkmcnt(0)":::"memory");
  float rli[16];
  #pragma unroll
  for(int r=0;r<16;++r)rli[r]=__builtin_amdgcn_rcpf(wsf[32+crow(r,hi)]);
  bf16*Ow=O+(rowbase+q0+wid*QBLK)*DM+h*D; const bf16*Gw=SG+(rowbase+q0+wid*QBLK)*DM+h*D;
  { bf16*stg=(bf16*)(shm+LDS_OST)+wid*2048;
    #pragma unroll
    for(int r=0;r<16;++r){const int orow=crow(r,hi);
      #pragma unroll
      for(int d0=0;d0<2;++d0)stg[orow*64+d0*32+r32]=__float2bfloat16(o[d0][r]*rli[r]);}
    asm volatile("s_waitcnt lgkmcnt(0)":::"memory");
    #pragma unroll
    for(int i=0;i<4;++i){const int row=i*8+(lane>>3),ch=lane&7; u32x4 v=*(const u32x4*)(stg+row*64+ch*8); const u32x4 gv=*(const u32x4*)(Gw+(long)row*DM+ch*8);
      #pragma unroll
      for(int e=0;e<4;++e){ const float a0=__uint_as_float(v[e]<<16),a1=__uint_as_float(v[e]&0xffff0000u),g0=__uint_as_float(gv[e]<<16),g1=__uint_as_float(gv[e]&0xffff0000u); v[e]=cvtpk_s(a0*g0,a1*g1); }
      ATTN_STORE16(Ow+(long)row*DM+ch*8,v);} }
  asm volatile("s_waitcnt lgkmcnt(0)\n\ts_barrier":::"memory");
  #undef DMA_K
  #undef DMA_V
  #undef CMASK
  #undef CINIT
  #undef START
  #undef RESC
  #undef ROT
}
constexpr int ATTN_LDS_BYTES=LDS_BYTES;
struct AttnTensors { const bf16* Q; const bf16* K; const bf16* V; bf16* O; const bf16* SG; const float* logf; };
__device__ __forceinline__ void fox_scan(char*shm,const float*__restrict__ logf,int bh,const int tid,float*__restrict__ nbout){
  const int lane=tid&63,wid=tid>>6; const int b=bh/NHEAD,h=bh%NHEAD;
  const float*src=logf+((long)b*SEQ+(long)tid*8)*NHEAD+h; float v[8];
  #pragma unroll
  for(int i=0;i<8;++i)v[i]=src[i*NHEAD];
  #pragma unroll
  for(int i=1;i<8;++i)v[i]+=v[i-1];
  const float tot=v[7]; float sc=tot;
  #pragma unroll
  for(int off=1;off<64;off<<=1){const float o_=__shfl_up(sc,off); if(lane>=off)sc+=o_;}
  float*wt=(float*)(shm+LDS_WT);
  __syncthreads();
  if(lane==63)wt[wid]=sc;
  __syncthreads();
  float woff=0.f;
  #pragma unroll
  for(int w=0;w<8;++w)woff+=(w<wid)?wt[w]:0.f;
  const float excl=woff+sc-tot;
  f32x4v o0,o1; o0[0]=-(excl+v[0])*1.4426950408889634f; o0[1]=-(excl+v[1])*1.4426950408889634f; o0[2]=-(excl+v[2])*1.4426950408889634f; o0[3]=-(excl+v[3])*1.4426950408889634f;
  o1[0]=-(excl+v[4])*1.4426950408889634f; o1[1]=-(excl+v[5])*1.4426950408889634f; o1[2]=-(excl+v[6])*1.4426950408889634f; o1[3]=-(excl+v[7])*1.4426950408889634f;
  f32x4v*dst=(f32x4v*)(nbout+(long)bh*SEQ+tid*8); dst[0]=o0; dst[1]=o1;
  __syncthreads();
}
template<int THRL=8> __device__ __forceinline__ void attn_phase(char*lds,const AttnTensors&T,const int tid0,unsigned*counter,const float*__restrict__ nbg,float thr){
  volatile unsigned*wq=(volatile unsigned*)(lds+LDS_WT)+8;
  for(;;){
    if(tid0==0){ const unsigned u_=__hip_atomic_fetch_add(counter,1u,__ATOMIC_RELAXED,__HIP_MEMORY_SCOPE_AGENT); *wq=u_; }
    __syncthreads();
    const unsigned u=*wq;
    if(u>=(unsigned)(BATCH*NHEAD*NQB))break;
    const int qb=NQB-1-(int)(u/(BATCH*NHEAD)), bh=(int)(u%(BATCH*NHEAD));
    { const f32x4v*src=(const f32x4v*)(nbg+(long)bh*SEQ); f32x4v*dst=(f32x4v*)(lds+LDS_NB); const int n4=(qb+1)*(QB/4); for(int i=tid0;i<n4;i+=NW*64)dst[i]=src[i]; }
    __syncthreads();
    const float*nb=(const float*)(lds+LDS_NB); const int NT0=(QB/KVBLK)*(qb+1); const float ref=nb[qb*QB]-thr;
    int lo=0,hi=NT0; while(lo<hi){ const int mid=(lo+hi)>>1; if(nb[KVBLK*mid+KVBLK-1]<ref)lo=mid+1; else hi=mid; }
    int ts=lo&~1; if(ts>NT0-4)ts=NT0-4;
    int tid=tid0; asm volatile("":"+v"(tid));
    attn_unit<THRL>(bh/NHEAD,bh%NHEAD,qb,ts,T.Q,T.K,T.V,T.O,T.SG,lds,tid);
  }
}
#undef SBAR
#undef WAIT_BAR
}

constexpr size_t MiB = 1u << 20;
constexpr size_t WS_SSQ = 65536;
constexpr size_t WS_LOGF = 2 * MiB;
constexpr size_t WS_WPOOL = 4 * MiB, WPOOL_L = 2 * MiB;
constexpr size_t WS_WOUT = 8 * MiB, WOUT_L = 8 * MiB;
constexpr size_t WS_WIN = 24 * MiB, WIN_L = 33 * MiB;
constexpr size_t WS_WD = 90 * MiB, WD_L = 22 * MiB;
constexpr size_t WS_WGU = 178 * MiB, WGU_L = 44 * MiB;
constexpr size_t WS_HB = 354 * MiB;
constexpr size_t WS_Q = 418 * MiB, ACT_MD = 64 * MiB;
constexpr size_t WS_ACT = 674 * MiB;
constexpr size_t WS_NBG = 850 * MiB;
constexpr size_t WS_END = 852 * MiB;
constexpr size_t CTL_ATTN_CNT = 14336;
static_assert((size_t)NIN_PAD * DM * 2 == WIN_L && (size_t)DM * FF * 2 == WD_L && (size_t)NGU * DM * 2 == WGU_L && (size_t)M * DM * 2 == ACT_MD && (size_t)M * FF * 2 == 176 * MiB, "ws map");

#ifndef SKEW_US
#define SKEW_US 0
#endif
#ifndef PROBE_DUP
#define PROBE_DUP 0
#endif
constexpr int LDS_BYTES = 147456;
constexpr int NWAVES = 8;
static_assert(attn_body::LDS_BYTES <= 131072, "attention LDS");

#define LAS __attribute__((address_space(3)))
typedef unsigned short bf16;
typedef unsigned v4u __attribute__((ext_vector_type(4)));
typedef unsigned v2u __attribute__((ext_vector_type(2)));
typedef float f32x4 __attribute__((ext_vector_type(4)));
#define LDS_WAIT() asm volatile("s_waitcnt lgkmcnt(0)" ::: "memory")
__device__ __forceinline__ unsigned pk2(float lo, float hi) { return pg8::cvt_pk_bf16(lo, hi); }
__device__ __forceinline__ float wave_sum(float v) {
#pragma unroll
    for (int o = 1; o < 64; o <<= 1) v += __shfl_xor(v, o);
    return v;
}

__device__ __forceinline__ int map_row_gu(int n) { const int j = n < FF ? n : n - FF; return (j >> 7) * 256 + (n < FF ? 0 : 128) + (j & 127); }
__device__ __forceinline__ int map_row_in(int n) { if (n >= 4 * DM) return n; const int t = n >> 11, r = n & 2047, head = r >> 6, d = r & 63; return (t * 8 + (head >> 2)) * 256 + (d >> 5) * 128 + (head & 3) * 32 + (d & 31); }
template <int MAP> __device__ __forceinline__ void tr_item(const float* __restrict__ W, int K, int N, bf16* __restrict__ WT, const float* __restrict__ gain, LAS float* scr, int kb, int nb, int lane) {
    const int k0 = kb * 64, n0 = nb * 64, n4 = lane & 15, kr = lane >> 4;
    const bool nok = (n0 + 4 * n4) < N;
#pragma unroll 8
    for (int i = 0; i < 16; ++i) { const int kk = 4 * i + kr; f32x4 v = (f32x4){0.f, 0.f, 0.f, 0.f};
        if (nok) v = *(const f32x4*)(W + (size_t)(k0 + kk) * N + n0 + 4 * n4);
        if (gain) v = v * gain[k0 + kk];
        LAS float* s = scr + kk * 65 + 4 * n4; s[0] = v[0]; s[1] = v[1]; s[2] = v[2]; s[3] = v[3]; }
    LDS_WAIT();
    const int c = lane & 7;
#pragma unroll
    for (int j = 0; j < 8; ++j) { const int n = (lane >> 3) + 8 * j;
        if (n0 + n < N) { const LAS float* s = scr + (8 * c) * 65 + n;
            v4u o; o.x = pk2(s[0 * 65], s[1 * 65]); o.y = pk2(s[2 * 65], s[3 * 65]); o.z = pk2(s[4 * 65], s[5 * 65]); o.w = pk2(s[6 * 65], s[7 * 65]);
            const int nn = n0 + n; const int row = MAP == 1 ? map_row_gu(nn) : (MAP == 2 ? map_row_in(nn) : nn);
            *(v4u*)(WT + (size_t)row * K + k0 + 8 * c) = o; } }
    LDS_WAIT();
}

constexpr size_t WS_CTL = 0, CTL_ZERO_BYTES = 16384;
constexpr int MISC_OFF = LDS_BYTES - 64;
#define GAS __attribute__((address_space(1)))
typedef GAS unsigned gu32;
typedef GAS unsigned long long gu64;
#define RLX_AGENT __ATOMIC_RELAXED, __HIP_MEMORY_SCOPE_AGENT
#define VM_WAIT() asm volatile("s_waitcnt vmcnt(0)" ::: "memory")
__device__ __forceinline__ unsigned long long rt() { return __builtin_amdgcn_s_memrealtime(); }
#define XB_TMO      128
#define XB_XCNT(j)  (256  + 64 * (j))
#define XB_XSUB(j)  (1280 + 64 * (j))
#define XB_XGEN(j)  (2304 + 64 * (j))
#define XB_TOP      3328
#define XB_TOPGEN   3392
#define XCD_BAR_WORDS 3456
#define XB_SPIN_CAP (1u << 18)

__device__ __forceinline__ unsigned xb_ld(unsigned* p)              { return __hip_atomic_load(p, __ATOMIC_RELAXED, __HIP_MEMORY_SCOPE_AGENT); }
__device__ __forceinline__ unsigned xb_add(unsigned* p, unsigned v) { return __hip_atomic_fetch_add(p, v, __ATOMIC_RELAXED, __HIP_MEMORY_SCOPE_AGENT); }
__device__ __forceinline__ unsigned xb_xcc_id() { return (unsigned)__builtin_amdgcn_s_getreg((3 << 11) | 20) & 0xFu; }
#define XB_SPIN(cond, bar) do { unsigned _sp = 0; while (cond) { __builtin_amdgcn_s_sleep(1); \
    if ((++_sp & 255u) == 0u) { if (xb_ld(&(bar)[XB_TMO])) break; if (_sp > XB_SPIN_CAP) { atomicAdd(&(bar)[XB_TMO], 1u); break; } } } } while (0)

struct XcdBarrier {
    unsigned* bar; unsigned x;
    volatile LAS unsigned* st;
};

__device__ __forceinline__ XcdBarrier xcd_barrier_post(unsigned* bar, volatile LAS unsigned* st) {
    XcdBarrier b; b.bar = bar; b.x = xb_xcc_id(); b.st = st;
    if (threadIdx.x == 0) (void)xb_add(&bar[XB_XCNT(b.x)], 1u);
    return b;
}
__device__ __forceinline__ void xcd_barrier_complete(unsigned* bar, unsigned x, unsigned& nloc, unsigned& nx) {
    const unsigned G = gridDim.x * gridDim.y * gridDim.z;
    unsigned sum, cnt, mine, sp = 0u;
    for (;;) {
        sum = 0u; cnt = 0u; mine = 0u;
#pragma unroll
        for (unsigned j = 0; j < 16; ++j) { const unsigned c = xb_ld(&bar[XB_XCNT(j)]); sum += c; cnt += (c > 0u) ? 1u : 0u; mine = (j == x) ? c : mine; }
        if (sum == G) break;
        __builtin_amdgcn_s_sleep(1);
        if ((++sp & 255u) == 0u) { if (xb_ld(&bar[XB_TMO])) break; if (sp > XB_SPIN_CAP) { atomicAdd(&bar[XB_TMO], 1u); break; } }
    }
    nloc = mine > 0u ? mine : 1u; nx = cnt > 0u ? cnt : 1u;
}

__device__ __forceinline__ void xcd_barrier(const XcdBarrier& b) {
    asm volatile("s_waitcnt vmcnt(0)" ::: "memory");
    __syncthreads();
    if (threadIdx.x == 0) {
        unsigned* bar = b.bar;
        __builtin_amdgcn_s_waitcnt(0);
        unsigned nloc = b.st[0], nx = b.st[1];
        if (nloc == 0u) { xcd_barrier_complete(bar, b.x, nloc, nx); b.st[0] = nloc; b.st[1] = nx; }
        const unsigned old = xb_add(&bar[XB_XSUB(b.x)], 1u);
        const unsigned gen = old / nloc;
        if (old + 1u == (gen + 1u) * nloc) {
            __builtin_amdgcn_fence(__ATOMIC_RELEASE, "agent");
            asm volatile("s_waitcnt vmcnt(0)" ::: "memory");
            const unsigned og = xb_add(&bar[XB_TOP], 1u);
            const unsigned tg = og / nx;
            if (og + 1u == (tg + 1u) * nx) xb_add(&bar[XB_TOPGEN], 1u);
            else XB_SPIN(xb_ld(&bar[XB_TOPGEN]) == tg, bar);
            __builtin_amdgcn_fence(__ATOMIC_ACQUIRE, "agent");
            xb_add(&bar[XB_XGEN(b.x)], 1u);
            asm volatile("s_waitcnt vmcnt(0)" ::: "memory");
        } else {
            XB_SPIN(xb_ld(&bar[XB_XGEN(b.x)]) == gen, bar);
            __builtin_amdgcn_fence(__ATOMIC_ACQUIRE, "agent");
            asm volatile("s_waitcnt vmcnt(0)" ::: "memory");
        }
    }
    __syncthreads();
}

struct Args { const float* in[15]; int ph_lo, ph_hi; };

constexpr int NPHASE = 20;
__device__ __forceinline__ void phase_info(int ph, int& type, int& layer) {
    if (ph == 0) { type = 0; layer = 0; return; }
    if (ph == NPHASE - 1) { type = 8; layer = 0; return; }
    int p = ph - 1; int l = 0;
    if (p >= 4) { p -= 4; l = 1; if (p >= 5) { p -= 5; l = 2; if (p >= 4) { p -= 4; l = 3; } } }
    layer = l;
    if ((l & 1) == 0) type = (p == 0) ? 1 : (p == 1) ? 2 : (p == 2) ? 3 : 4;
    else type = (p == 0) ? 5 : (p == 1) ? 6 : (p == 2) ? 7 : (p == 3) ? 3 : 4;
}

__global__ void __launch_bounds__(NWAVES * 64, 2) fwd_kernel(Args args) {
    extern __shared__ __attribute__((aligned(16))) unsigned char lds[];
    cg::grid_group grid = cg::this_grid();
    LAS unsigned char* ldsl = (LAS unsigned char*)lds;
    volatile LAS unsigned* MISC = (volatile LAS unsigned*)(ldsl + MISC_OFF);
    if (threadIdx.x < 16) MISC[threadIdx.x] = 0u;
    __syncthreads();
    XcdBarrier bar = xcd_barrier_post((unsigned*)((unsigned char*)args.in[14] + WS_CTL), MISC);

    for (int ph = args.ph_lo; ph < args.ph_hi; ++ph) {
        int php = ph; bool dry = false;
        if (PROBE_DUP >> 1) { int cnt = 0; for (php = 0; php < NPHASE; ++php) { const int n = 1 + (((PROBE_DUP >> 1) >> php) & 1); if (ph < cnt + n) { dry = (n == 2 && ph == cnt); break; } cnt += n; } }
        int type, layer; phase_info(php, type, layer);
        int tid = threadIdx.x; asm volatile("" : "+v"(tid)); int bx = blockIdx.x; asm volatile("" : "+s"(bx)); int G = gridDim.x; asm volatile("" : "+s"(G));
        const int lane = tid & 63, wave = __builtin_amdgcn_readfirstlane(tid >> 6);
        const int vcu = (G % 8 == 0) ? (bx % 8) * (G / 8) + bx / 8 : bx;
        const int j2 = layer >> 1;
        int z = 0; asm volatile("" : "+s"(z));
        unsigned char* ws = (unsigned char*)args.in[14 + z];
        const float* x = args.in[0 + z]; const float* attn_g = args.in[1 + z]; const float* ffn_g = args.in[2 + z]; const float* final_g = args.in[3 + z];
        const float* pool_w = args.in[4 + z]; const float* pool_scale = args.in[5 + z]; const float* w_in = args.in[6 + z]; const float* b_f = args.in[7 + z];
        const float* qn_g = args.in[8 + z]; const float* kn_g = args.in[9 + z]; const float* w_out = args.in[10 + z]; const float* w_gu = args.in[11 + z]; const float* w_dn = args.in[12 + z];
        float* H = (float*)args.in[13 + z];
        pg8::ssq_t* SSQ = (pg8::ssq_t*)(ws + WS_SSQ); float* LOGF = (float*)(ws + WS_LOGF);
        bf16* HB = (bf16*)(ws + WS_HB); bf16* QB = (bf16*)(ws + WS_Q); bf16* ACT = (bf16*)(ws + WS_ACT);
        if (SKEW_US > 0 && (type == 2 || type == 4 || type == 7)) {
            const unsigned long long t0 = __builtin_amdgcn_s_memrealtime(), dt = (unsigned long long)((vcu & 3) * SKEW_US * 100);
            while (__builtin_amdgcn_s_memrealtime() - t0 < dt) __builtin_amdgcn_s_sleep(16);
        }
        switch (type) {
        case 0: {
            LAS float* scr = (LAS float*)(ldsl + wave * 16640);
            const int gw = vcu * NWAVES + wave, NGW = G * NWAVES;
            constexpr int I_GU = 32 * 176, I_DN = 88 * 32, I_IN = 32 * 129, I_OUT = 32 * 32, I_PL = 8 * 8;
            constexpr int T_GU = 4 * I_GU, T_DN = 4 * I_DN, T_IN = 2 * I_IN, T_OUT = 2 * I_OUT, T_PL = 8 * I_PL;
            for (int it = gw; it < T_GU + T_DN + T_IN + T_OUT + T_PL; it += NGW) {
                int r = it;
                if (r < T_GU) { const int l = r / I_GU; r %= I_GU; tr_item<1>(w_gu + (size_t)l * DM * NGU, DM, NGU, (bf16*)(ws + WS_WGU + l * WGU_L), ffn_g + l * DM, scr, (r / (8 * 176)) * 8 + (r & 7), (r % (8 * 176)) >> 3, lane); continue; } r -= T_GU;
                if (r < T_DN) { const int l = r / I_DN; r %= I_DN; tr_item<0>(w_dn + (size_t)l * FF * DM, FF, DM, (bf16*)(ws + WS_WD + l * WD_L), nullptr, scr, (r / (8 * 32)) * 8 + (r & 7), (r % (8 * 32)) >> 3, lane); continue; } r -= T_DN;
                if (r < T_IN) { const int l = r / I_IN; r %= I_IN; tr_item<2>(w_in + (size_t)l * DM * NIN, DM, NIN, (bf16*)(ws + WS_WIN + l * WIN_L), attn_g + (2 * l + 1) * DM, scr, (r / (8 * 129)) * 8 + (r & 7), (r % (8 * 129)) >> 3, lane); continue; } r -= T_IN;
                if (r < T_OUT) { const int l = r / I_OUT; r %= I_OUT; tr_item<0>(w_out + (size_t)l * DM * DM, DM, DM, (bf16*)(ws + WS_WOUT + l * WOUT_L), nullptr, scr, (r / (8 * 32)) * 8 + (r & 7), (r % (8 * 32)) >> 3, lane); continue; } r -= T_OUT;
                { const int lg = r / I_PL; r %= I_PL; tr_item<0>(pool_w + (size_t)lg * PG * PG, PG, PG, (bf16*)(ws + WS_WPOOL) + (size_t)lg * PG * PG, nullptr, scr, (r / (8 * 8)) * 8 + (r & 7), (r % (8 * 8)) >> 3, lane); }
            }
            for (int m = gw; m < M; m += NGW) {
                const f32x4* xr = (const f32x4*)(x + (size_t)m * DM) + lane; float s = 0.f; f32x4 v[8];
#pragma unroll
                for (int j = 0; j < 8; ++j) { v[j] = xr[64 * j]; const f32x4 q = v[j] * v[j]; s += (q[0] + q[1]) + (q[2] + q[3]); }
                s = wave_sum(s);
                v2u* o8 = (v2u*)(HB + (size_t)m * DM) + lane;
#pragma unroll
                for (int j = 0; j < 8; ++j) { v2u w; w.x = pk2(v[j][0], v[j][1]); w.y = pk2(v[j][2], v[j][3]); o8[64 * j] = w; }
                if (lane == 0) SSQ[m] = (pg8::ssq_t)(s * pg8::SSQ_SCALE);
            }
            for (int i = bx * (NWAVES * 64) + tid; i < 8 * M; i += G * NWAVES * 64) SSQ[M + i] = 0ull;
        } break;
        case 1: {
            const pg8::ssq_t* ssq = SSQ + (size_t)(2 * layer) * M;
            const int tl = tid & 255, c8 = tl * 8, win = 2 << (tl >> 6), half = tid >> 8;
            const f32x4 ga = *(const f32x4*)(attn_g + layer * DM + c8), gb = *(const f32x4*)(attn_g + layer * DM + c8 + 4);
#define HN_ROW(r, lo, hi) do { const v4u w_ = *(const v4u*)(HB + (size_t)(r) * DM + c8); const float rs_ = pg8::rstd_row(ssq, (r)); \
                lo = (f32x4){__uint_as_float(w_.x << 16), __uint_as_float(w_.x & 0xffff0000u), __uint_as_float(w_.y << 16), __uint_as_float(w_.y & 0xffff0000u)} * rs_; \
                hi = (f32x4){__uint_as_float(w_.z << 16), __uint_as_float(w_.z & 0xffff0000u), __uint_as_float(w_.w << 16), __uint_as_float(w_.w & 0xffff0000u)} * rs_; } while (0)
            for (int ch = vcu; ch < M / 64; ch += G) {
                const int t0 = ch * 64 + half * 32, tp0 = t0 & (SEQ - 1);
                f32x4 sa = (f32x4){0.f, 0.f, 0.f, 0.f}, sb = sa, va, vb;
                for (int j = 1; j < win; ++j) if (tp0 - j >= 0) { HN_ROW(t0 - j, va, vb); sa += va; sb += vb; }
                sa = sa * ga; sb = sb * gb;
#pragma unroll 8
                for (int i = 0; i < 32; ++i) { const int r = t0 + i;
                    HN_ROW(r, va, vb); va = va * ga; vb = vb * gb;
                    sa += va; sb += vb; const float ic = 1.0f / (float)min(tp0 + i + 1, win); const f32x4 fa = sa * ic - va, fb = sb * ic - vb;
                    v4u w; w.x = pk2(fa[0], fa[1]); w.y = pk2(fa[2], fa[3]); w.z = pk2(fb[0], fb[1]); w.w = pk2(fb[2], fb[3]); *(v4u*)(QB + (size_t)r * DM + c8) = w;
                    if (tp0 + i - (win - 1) >= 0) { f32x4 oa, ob; HN_ROW(r - (win - 1), oa, ob); sa -= oa * ga; sb -= ob * gb; } }
            }
#undef HN_ROW
        } break;
        case 2: {
            pg8::Gemm g{QB, (const bf16*)(ws + WS_WPOOL + j2 * WPOOL_L), M, DM, PG, DM, 2}; pg8::StaticOrder S; S.init(M, DM, G, bx);
            pg8::EpiResid<true, false> E{HB, nullptr, SSQ + (size_t)(2 * layer + 1) * M, pool_scale + j2 * DM};
            pg8::gemm_phase<pg8::EpiResid<true, false>>(ldsl, g, S, E, tid);
        } break;
        case 3: {
            pg8::Gemm g{HB, (const bf16*)(ws + WS_WGU + layer * WGU_L), M, NGU, DM, DM, 1 << 20}; pg8::StaticOrder S; S.init(M, NGU, G, bx);
            pg8::EpiSwiglu E{ACT, SSQ + (size_t)(2 * layer + 1) * M};
            pg8::gemm_phase<pg8::EpiSwiglu>(ldsl, g, S, E, tid);
        } break;
        case 4: case 7: {
            pg8::Gemm g{ACT, (type == 4) ? (const bf16*)(ws + WS_WD + layer * WD_L) : (const bf16*)(ws + WS_WOUT + j2 * WOUT_L), M, DM, (type == 4) ? FF : DM, (type == 4) ? FF : DM, 1 << 20};
            pg8::StaticOrder S; S.init(M, DM, G, bx);
            pg8::EpiResid<false, false> E{HB, nullptr, SSQ + (size_t)(2 * layer + ((type == 4) ? 2 : 1)) * M, nullptr};
            pg8::gemm_phase<pg8::EpiResid<false, false>>(ldsl, g, S, E, tid);
        } break;
        case 5: {
            pg8::Gemm g{HB, (const bf16*)(ws + WS_WIN + j2 * WIN_L), M, 4 * DM, DM, DM, 1 << 20}; pg8::StaticOrder S; S.init(M, 4 * DM, G, bx);
            pg8::EpiFoxIn E{QB, (size_t)M * DM, LOGF, SSQ + (size_t)(2 * layer) * M, b_f + j2 * NH, qn_g + j2 * HD, kn_g + j2 * HD, attn_body::C2};
            pg8::gemm_phase<pg8::EpiFoxIn>(ldsl, g, S, E, tid);
            {
                typedef float f32x16 __attribute__((ext_vector_type(16))); typedef short bf16x8v __attribute__((ext_vector_type(8)));
                const int r32 = lane & 31, hi = lane >> 5; const bf16* Wf = (const bf16*)(ws + WS_WIN + j2 * WIN_L) + (size_t)(4 * DM) * DM;
                const pg8::ssq_t* ssq = SSQ + (size_t)(2 * layer) * M; LAS float* red = (LAS float*)ldsl;
                for (int rb = vcu; rb < M / 64; rb += G) {
                    f32x16 d0 = {}, d1 = {};
                    const bf16* a0p = HB + (size_t)(rb * 64 + r32) * DM + wave * 256 + 8 * hi; const bf16* bp = Wf + (size_t)r32 * DM + wave * 256 + 8 * hi;
#pragma unroll 8
                    for (int ks = 0; ks < 16; ++ks) { const bf16x8v a0 = *(const bf16x8v*)(a0p + ks * 16), a1 = *(const bf16x8v*)(a0p + (size_t)32 * DM + ks * 16), b = *(const bf16x8v*)(bp + ks * 16);
                        d0 = __builtin_amdgcn_mfma_f32_32x32x16_bf16(a0, b, d0, 0, 0, 0); d1 = __builtin_amdgcn_mfma_f32_32x32x16_bf16(a1, b, d1, 0, 0, 0); }
#pragma unroll
                    for (int r = 0; r < 16; ++r) { red[((wave * 2 + 0) * 16 + r) * 64 + lane] = d0[r]; red[((wave * 2 + 1) * 16 + r) * 64 + lane] = d1[r]; }
                    __syncthreads();
                    { const int blk = tid >> 8, l2 = tid & 63, q4 = (tid >> 6) & 3, j = l2 & 31, h2 = l2 >> 5; const float bias = b_f[j2 * NH + j];
#pragma unroll
                      for (int rr = 0; rr < 4; ++rr) { const int r = 4 * q4 + rr; float s = 0.f;
#pragma unroll
                          for (int w = 0; w < 8; ++w) s += red[((w * 2 + blk) * 16 + r) * 64 + l2];
                          const int row = rb * 64 + blk * 32 + (r & 3) + 8 * (r >> 2) + 4 * h2;
                          const float zv = s * pg8::rstd_row(ssq, row) + bias;
                          LOGF[(size_t)row * NH + j] = fminf(zv, 0.f) - __logf(1.0f + __expf(-fabsf(zv))); } }
                    __syncthreads();
                }
            }
        } break;
        case 6: {
            const attn_body::AttnTensors AT{(const attn_body::bf16*)QB, (const attn_body::bf16*)(QB + (size_t)M * DM), (const attn_body::bf16*)(QB + 2 * (size_t)M * DM), (attn_body::bf16*)ACT,
                                            (const attn_body::bf16*)(QB + 3 * (size_t)M * DM), LOGF};
            float* NBG = (float*)(ws + WS_NBG);
            for (int bh = vcu; bh < BATCH * NH; bh += G) attn_body::fox_scan((char*)lds, LOGF, bh, tid, NBG);
            asm volatile("s_waitcnt vmcnt(0) lgkmcnt(0)" ::: "memory"); xcd_barrier(bar);
            float gqm = 0.f, gkm = 0.f;
            for (int i = 0; i < HD; ++i) { gqm = fmaxf(gqm, fabsf(qn_g[j2 * HD + i])); gkm = fmaxf(gkm, fabsf(kn_g[j2 * HD + i])); }
            const float thr = 2.0f * (8.0f * gqm * gkm * 1.4426950408889634f * 1.02f) + 40.0f;
            attn_body::attn_phase<8>((char*)lds, AT, tid, (unsigned*)(ws + WS_CTL + CTL_ATTN_CNT + j2 * 256), NBG, thr);
        } break;
        default: {
            const pg8::ssq_t* ssq = SSQ + (size_t)8 * M; const int gw = vcu * NWAVES + wave, NGW = G * NWAVES;
            for (int m = gw; m < M; m += NGW) { const float rs = pg8::rstd_row(ssq, m); f32x4* hr = (f32x4*)(H + (size_t)m * DM) + lane; const f32x4* gr = (const f32x4*)final_g + lane; const v2u* br = (const v2u*)(HB + (size_t)m * DM) + lane;
#pragma unroll
                for (int j = 0; j < 8; ++j) { const v2u w = br[64 * j]; hr[64 * j] = (f32x4){__uint_as_float(w.x << 16), __uint_as_float(w.x & 0xffff0000u), __uint_as_float(w.y << 16), __uint_as_float(w.y & 0xffff0000u)} * rs * gr[64 * j]; } }
        } break;
        }
        if (ph + 1 < args.ph_hi) { asm volatile("s_waitcnt vmcnt(0) lgkmcnt(0)" ::: "memory"); if (args.ph_hi < 0) grid.sync(); else xcd_barrier(bar);     if (PROBE_DUP & 1) xcd_barrier(bar); }
    }
}

#ifndef MK_PER_PHASE
#define MK_PER_PHASE 0
#endif
extern "C" void kernel_launch(void* const* d_in, const int* in_sizes, int n_in, void* d_out, int out_size, void* d_ws, size_t ws_size, hipStream_t stream) {
    static int grid = 0;
    if (grid == 0) {
        if (n_in != 13 || in_sizes[0] != M * DM || out_size != M * DM || ws_size < WS_END) { fprintf(stderr, "kernel_launch: unexpected shapes (n_in %d in0 %d out %d ws %zu)\n", n_in, n_in > 0 ? in_sizes[0] : -1, out_size, ws_size); grid = -1; return; }
        int dev = 0, cus = 0, per_cu = 0;
        (void)hipGetDevice(&dev); (void)hipDeviceGetAttribute(&cus, hipDeviceAttributeMultiprocessorCount, dev);
        if (hipFuncSetAttribute((const void*)fwd_kernel, hipFuncAttributeMaxDynamicSharedMemorySize, LDS_BYTES) != hipSuccess) { fprintf(stderr, "kernel_launch: hipFuncSetAttribute failed\n"); grid = -1; return; }
        (void)hipOccupancyMaxActiveBlocksPerMultiprocessor(&per_cu, (const void*)fwd_kernel, NWAVES * 64, LDS_BYTES);
        if (per_cu < 1) { fprintf(stderr, "kernel_launch: occupancy query says %d\n", per_cu); per_cu = 1; }
        (void)hipGetLastError();
        grid = cus * per_cu;
    }
    if (grid < 0) return;
    if (hipMemsetAsync((char*)d_ws + WS_CTL, 0, CTL_ZERO_BYTES, stream) != hipSuccess) { fprintf(stderr, "kernel_launch: memset failed\n"); return; }
    Args a{};
    for (int i = 0; i < 13; ++i) a.in[i] = (const float*)d_in[i];
    a.in[13] = (const float*)d_out; a.in[14] = (const float*)d_ws;
#if MK_PER_PHASE
    for (int ph = 0; ph < NPHASE; ++ph) { a.ph_lo = ph; a.ph_hi = ph + 1; hipLaunchKernelGGL(fwd_kernel, dim3(grid), dim3(NWAVES * 64), LDS_BYTES, stream, a); }
#else
    a.ph_lo = 0; a.ph_hi = NPHASE + __builtin_popcount((unsigned)PROBE_DUP >> 1);
    void* kargs[] = {&a};
    hipError_t e = hipLaunchCooperativeKernel((const void*)fwd_kernel, dim3(grid), dim3(NWAVES * 64), kargs, LDS_BYTES, stream);
    if (e != hipSuccess) fprintf(stderr, "cooperative launch failed: %s (grid %d)\n", hipGetErrorString(e), grid);
#endif
}
```

```cpp
#include <hip/hip_runtime.h>
#include <hip/hip_cooperative_groups.h>
#include <hip/hip_bf16.h>
#include <cstdio>
#include <cstdint>
#include <cmath>
namespace cg = cooperative_groups;

constexpr int BATCH = 4, SEQ = 4096, DM = 2048, M = BATCH * SEQ, NH = 32, HD = 64, FF = 5632, NGU = 2 * FF, NIN = 4 * DM + NH, NIN_PAD = 8448, PG = 512;
constexpr float RMS_EPS = 1e-6f;

namespace pg8 {
#define PG8_LAS __attribute__((address_space(3)))
typedef unsigned short bf16_t;
typedef short bf16x8 __attribute__((ext_vector_type(8)));
typedef float f32x4 __attribute__((ext_vector_type(4)));
typedef unsigned u32x4 __attribute__((ext_vector_type(4)));
constexpr int BM = 256, BK = 64, HALF = 128, HTB = HALF * BK * 2  , STAGE_BYTES = 8 * HTB, NXCD = 8, WGM = 4;

__host__ __device__ __forceinline__ int lds_byte(int r, int c) { const int st = (r >> 4) * 2 + (c >> 5), rr = r & 15, cc = c & 31, ob = rr * 64 + cc * 2; return st * 1024 + (ob ^ (((ob >> 9) & 1) << 5)); }
__host__ __device__ __forceinline__ void stage_rc(int b, int& R, int& C) { const int st = b / 1024, sb = b % 1024, swz = sb ^ (((sb >> 9) & 1) << 5); R = (st >> 1) * 16 + swz / 64; C = (st & 1) * 32 + (swz % 64) / 2; }
__host__ __device__ __forceinline__ int perm32(int rho) { const int n = rho >> 4, i = rho & 15; return 8 * (i >> 2) + 4 * n + (i & 3); }

struct Unit { int pm, pn; };
struct Gemm { const bf16_t* A; const bf16_t* Bt; int M, N, K, lda, gdiv; };

struct StaticOrder {
    int nM, nN, nwg, G, c;
    __host__ __device__ void init(int M_, int N_, int G_, int c_) { nM = M_ / BM; nN = N_ / BM; nwg = nM * nN; G = G_; c = c_; }
    __host__ __device__ bool next(int i, Unit& u) const {
        const long L = (long)i * G + c; if (L >= nwg) return false;
        int wgid = (int)L; { const int q = nwg / NXCD, r = nwg % NXCD, xcd = wgid % NXCD, off = wgid / NXCD; wgid = (xcd < r ? xcd * (q + 1) : r * (q + 1) + (xcd - r) * q) + off; }
        const int nig = WGM * nN, gid = wgid / nig, fm = gid * WGM, gsz = (nM - fm) < WGM ? (nM - fm) : WGM;
        u.pm = fm + ((wgid % nig) % gsz); u.pn = (wgid % nig) / gsz; return true;
    }
};

__device__ __forceinline__ unsigned cvt_pk_bf16(float lo, float hi) { unsigned r; asm volatile("v_cvt_pk_bf16_f32 %0, %1, %2" : "=v"(r) : "v"(lo), "v"(hi)); return r; }
typedef unsigned long long ssq_t;
constexpr float SSQ_SCALE = 16777216.0f;
__device__ __forceinline__ float rstd_row(const ssq_t* ssq, int row) { return rsqrtf((float)ssq[row] * (1.0f / (SSQ_SCALE * (float)DM)) + RMS_EPS); }
__device__ __forceinline__ float sigmoid_f(float v) { return __builtin_amdgcn_rcpf(1.0f + __builtin_amdgcn_exp2f(-1.4426950408889634f * v)); }

struct EpiFoxIn {
    static constexpr bool PERM = true;
    bf16_t* QKVG; size_t tstride;
    float* logf; const ssq_t* ssq; const float* bf; const float* gq; const float* gk; float qscale;
    __device__ __forceinline__ void operator()(const f32x4 (&acc)[2][2][4][2], const Unit& u, int wr, int wc, int fr, int fq) const {
        const int row0 = u.pm * BM + wr * 64 + fr;
        const int t = u.pn >> 3, head = (u.pn & 7) * 4 + wc;
        bf16_t* base = QKVG + (size_t)t * tstride + head * HD + 8 * fq;
        f32x4 gv[2][2];
#pragma unroll
        for (int bj = 0; bj < 2; ++bj)
#pragma unroll
            for (int n = 0; n < 2; ++n) { gv[bj][n] = (f32x4){1.f, 1.f, 1.f, 1.f};
                if (t < 2) gv[bj][n] = *(const f32x4*)((t == 0 ? gq : gk) + 32 * bj + 8 * fq + 4 * n) * (t == 0 ? qscale : 1.0f); }
#pragma unroll
        for (int ai = 0; ai < 2; ++ai)
#pragma unroll
            for (int m = 0; m < 4; ++m) { const int row = row0 + ai * HALF + m * 16; const float rs = rstd_row(ssq, row);
                f32x4 v[2][2]; float ss = 0.f;
#pragma unroll
                for (int bj = 0; bj < 2; ++bj)
#pragma unroll
                    for (int n = 0; n < 2; ++n) { v[bj][n] = acc[ai][bj][m][n] * rs; const f32x4 q = v[bj][n] * v[bj][n]; ss += (q[0] + q[1]) + (q[2] + q[3]); }
                if (t < 2) { ss += __shfl_xor(ss, 16); ss += __shfl_xor(ss, 32); const float rn = rsqrtf(ss * (1.0f / (float)HD) + RMS_EPS);
#pragma unroll
                    for (int bj = 0; bj < 2; ++bj)
#pragma unroll
                        for (int n = 0; n < 2; ++n) v[bj][n] = v[bj][n] * rn * gv[bj][n]; }
                if (t == 3) {
#pragma unroll
                    for (int bj = 0; bj < 2; ++bj)
#pragma unroll
                        for (int n = 0; n < 2; ++n)
#pragma unroll
                            for (int e = 0; e < 4; ++e) v[bj][n][e] = sigmoid_f(v[bj][n][e]); }
#pragma unroll
                for (int bj = 0; bj < 2; ++bj) { u32x4 w; w.x = cvt_pk_bf16(v[bj][0][0], v[bj][0][1]); w.y = cvt_pk_bf16(v[bj][0][2], v[bj][0][3]); w.z = cvt_pk_bf16(v[bj][1][0], v[bj][1][1]); w.w = cvt_pk_bf16(v[bj][1][2], v[bj][1][3]);
                    *(u32x4*)(base + (size_t)row * DM + 32 * bj) = w; } }
    }
};

struct EpiSwiglu {
    static constexpr bool PERM = true;
    bf16_t* O; const ssq_t* ssq;
    __device__ __forceinline__ void operator()(const f32x4 (&acc)[2][2][4][2], const Unit& u, int wr, int wc, int fr, int fq) const {
        const int row0 = u.pm * BM + wr * 64 + fr, col0 = u.pn * HALF + wc * 32 + 8 * fq;
#pragma unroll
        for (int ai = 0; ai < 2; ++ai)
#pragma unroll
            for (int m = 0; m < 4; ++m) { const int row = row0 + ai * HALF + m * 16; const float rs = rstd_row(ssq, row); f32x4 a[2];
#pragma unroll
                for (int n = 0; n < 2; ++n) { const f32x4 g = acc[ai][0][m][n] * rs, up = acc[ai][1][m][n] * rs;
#pragma unroll
                    for (int e = 0; e < 4; ++e) a[n][e] = g[e] * sigmoid_f(g[e]) * up[e]; }
                u32x4 w; w.x = cvt_pk_bf16(a[0][0], a[0][1]); w.y = cvt_pk_bf16(a[0][2], a[0][3]); w.z = cvt_pk_bf16(a[1][0], a[1][1]); w.w = cvt_pk_bf16(a[1][2], a[1][3]);
                *(u32x4*)(O + (size_t)row * FF + col0) = w; }
    }
};

template <bool HAS_SCALE, bool OUT_F32> struct EpiResid {
    static constexpr bool PERM = true;
    bf16_t* hb; float* outf; ssq_t* ssq_out; const float* colscale;
    __device__ __forceinline__ void operator()(f32x4 (&acc)[2][2][4][2], const Unit& u, int wr, int wc, int fr, int fq) const {
        const int row0 = u.pm * BM + wr * 64 + fr, col0 = u.pn * BM + wc * 32 + 8 * fq;
        if constexpr (HAS_SCALE) {
#pragma unroll
            for (int bj = 0; bj < 2; ++bj)
#pragma unroll
                for (int n = 0; n < 2; ++n) { const f32x4 sc = *(const f32x4*)(colscale + col0 + bj * HALF + 4 * n);
#pragma unroll
                    for (int ai = 0; ai < 2; ++ai)
#pragma unroll
                        for (int m = 0; m < 4; ++m) acc[ai][bj][m][n] = acc[ai][bj][m][n] * sc; }
        }
        u32x4 b[2][2];
#define ER_LOAD(g) _Pragma("unroll") for (int mm = 0; mm < 2; ++mm) _Pragma("unroll") for (int bj = 0; bj < 2; ++bj) b[mm][bj] = *(const u32x4*)(hb + (size_t)(row0 + ((g) >> 1) * HALF + (2 * ((g) & 1) + mm) * 16) * DM + col0 + bj * HALF);
#define ER_COMP(g) _Pragma("unroll") for (int mm = 0; mm < 2; ++mm) _Pragma("unroll") for (int bj = 0; bj < 2; ++bj) { const u32x4 w = b[mm][bj]; \
            acc[(g) >> 1][bj][2 * ((g) & 1) + mm][0] += (f32x4){__uint_as_float(w.x << 16), __uint_as_float(w.x & 0xffff0000u), __uint_as_float(w.y << 16), __uint_as_float(w.y & 0xffff0000u)}; \
            acc[(g) >> 1][bj][2 * ((g) & 1) + mm][1] += (f32x4){__uint_as_float(w.z << 16), __uint_as_float(w.z & 0xffff0000u), __uint_as_float(w.w << 16), __uint_as_float(w.w & 0xffff0000u)}; }
#define ER_STORE(g) _Pragma("unroll") for (int mm = 0; mm < 2; ++mm) { const int ai = (g) >> 1, m = 2 * ((g) & 1) + mm; const int row = row0 + ai * HALF + m * 16; const size_t off = (size_t)row * DM + col0; float ss = 0.f; \
            _Pragma("unroll") for (int bj = 0; bj < 2; ++bj) { const f32x4 o0 = acc[ai][bj][m][0], o1 = acc[ai][bj][m][1]; \
                const f32x4 q0 = o0 * o0, q1 = o1 * o1; ss += ((q0[0] + q0[1]) + (q0[2] + q0[3])) + ((q1[0] + q1[1]) + (q1[2] + q1[3])); \
                if constexpr (OUT_F32) { *(f32x4*)(outf + off + bj * HALF) = o0; *(f32x4*)(outf + off + bj * HALF + 4) = o1; } \
                else { u32x4 v; v.x = cvt_pk_bf16(o0[0], o0[1]); v.y = cvt_pk_bf16(o0[2], o0[3]); v.z = cvt_pk_bf16(o1[0], o1[1]); v.w = cvt_pk_bf16(o1[2], o1[3]); *(u32x4*)(hb + off + bj * HALF) = v; } } \
            ss += __shfl_xor(ss, 16); ss += __shfl_xor(ss, 32); \
            if (fq == 0) (void)__hip_atomic_fetch_add(ssq_out + row, (ssq_t)(ss * SSQ_SCALE), __ATOMIC_RELAXED, __HIP_MEMORY_SCOPE_AGENT); }
#define ER_FENCE asm volatile("" ::: "memory");
        ER_LOAD(0) ER_FENCE ER_COMP(0) ER_FENCE
        ER_LOAD(1) ER_FENCE ER_STORE(0) ER_FENCE ER_COMP(1) ER_FENCE
        ER_LOAD(2) ER_FENCE ER_STORE(1) ER_FENCE ER_COMP(2) ER_FENCE
        ER_LOAD(3) ER_FENCE ER_STORE(2) ER_FENCE ER_COMP(3) ER_FENCE
        ER_STORE(3)
#undef ER_LOAD
#undef ER_COMP
#undef ER_STORE
#undef ER_FENCE
    }
};

template <class Epi>
__device__ __forceinline__ void gemm_phase(PG8_LAS unsigned char* lds, const Gemm g, const StaticOrder& S, const Epi& E, const int tid) {
    const int wid = __builtin_amdgcn_readfirstlane(tid >> 6), lane = tid & 63, wr = wid >> 2, wc = wid & 3, fr = lane & 15, fq = lane >> 4;
    const int K = g.K, nt = K / BK, lda = g.lda;
    unsigned voffA[2], voffB[2];
#pragma unroll
    for (int i = 0; i < 2; ++i) { int R, C; stage_rc(tid * 16 + i * 8192, R, C); const int Rb = Epi::PERM ? ((R & ~31) + perm32(R & 31)) : R;
        voffA[i] = (unsigned)(R * lda + C) * 2u; voffB[i] = (unsigned)(Rb * K + C) * 2u; }
    const size_t kstep = (size_t)(BK * 2);
    const size_t hsA = (size_t)HALF * lda * 2, hsB = (size_t)HALF * K * 2;
    const size_t tsA = 2 * hsA, tsB = 2 * hsB;
    const size_t gsA = (size_t)K * 2;
    const unsigned ldsw = (unsigned)wid * 1024u;
    const int aoff = lds_byte(wr * 64 + fr, fq * 8), boff = lds_byte(wc * 32 + fr, fq * 8);
#define PG8_UA(u) ((const char*)g.A + (size_t)(u).pm * tsA + (size_t)((u).pn / g.gdiv) * gsA)
#define PG8_UB(u) ((const char*)g.Bt + (size_t)(u).pn * tsB)
#define PG8_SA(b, h) (((b) * 2 + (h)) * HTB)
#define PG8_SB(b, h) ((4 + (b) * 2 + (h)) * HTB)
#define PG8_STAGE(bufoff, gbase, voff) do { _Pragma("unroll") for (int _i = 0; _i < 2; ++_i) \
        __builtin_amdgcn_global_load_lds((const unsigned*)((const char*)(gbase) + (voff)[_i]), (PG8_LAS unsigned*)(lds + (bufoff) + ldsw + _i * 8192), 16, 0, 0); } while (0)
#define PG8_LDA(dst, b, h) do { _Pragma("unroll") for (int m = 0; m < 4; ++m) _Pragma("unroll") for (int k = 0; k < 2; ++k) dst[m][k] = *(const PG8_LAS bf16x8*)(lds + PG8_SA(b, h) + aoff + m * 2048 + k * 1024); } while (0)
#define PG8_LDB(dst, b, h) do { _Pragma("unroll") for (int n = 0; n < 2; ++n) _Pragma("unroll") for (int k = 0; k < 2; ++k) dst[n][k] = *(const PG8_LAS bf16x8*)(lds + PG8_SB(b, h) + boff + n * 2048 + k * 1024); } while (0)
#define PG8_MMA(ai, bj, At, Bt) do { __builtin_amdgcn_s_setprio(1); _Pragma("unroll") for (int m = 0; m < 4; ++m) _Pragma("unroll") for (int n = 0; n < 2; ++n) _Pragma("unroll") for (int k = 0; k < 2; ++k) \
        acc[ai][bj][m][n] = __builtin_amdgcn_mfma_f32_16x16x32_bf16(Bt[n][k], At[m][k], acc[ai][bj][m][n], 0, 0, 0); __builtin_amdgcn_s_setprio(0); } while (0)
#define PG8_WAIT_V(n) asm volatile("s_waitcnt vmcnt(" #n ")" ::: "memory")
#define PG8_WAIT_L(n) asm volatile("s_waitcnt lgkmcnt(" #n ")" ::: "memory")
#define PG8_BAR __builtin_amdgcn_s_barrier()
#define PG8_SCHED __builtin_amdgcn_sched_barrier(0)
    Unit cur, nxt; int ui = 0;
    if (!S.next(0, cur)) return;
    f32x4 acc[2][2][4][2];
#pragma unroll
    for (int a = 0; a < 2; ++a)
#pragma unroll
        for (int b = 0; b < 2; ++b)
#pragma unroll
            for (int m = 0; m < 4; ++m)
#pragma unroll
                for (int n = 0; n < 2; ++n) acc[a][b][m][n] = (f32x4){0.f, 0.f, 0.f, 0.f};
    bf16x8 At[4][2], B0[2][2], B1[2][2];
    const char* cA = PG8_UA(cur); const char* cB = PG8_UB(cur);
    PG8_STAGE(PG8_SB(0, 0), cB, voffB); PG8_STAGE(PG8_SB(0, 1), cB + hsB, voffB); PG8_STAGE(PG8_SA(0, 0), cA, voffA); PG8_STAGE(PG8_SA(0, 1), cA + hsA, voffA);
    if (wr == 1) PG8_BAR;
    PG8_WAIT_V(2); PG8_BAR;
    PG8_STAGE(PG8_SB(1, 0), cB + kstep, voffB); PG8_STAGE(PG8_SA(1, 0), cA + kstep, voffA); PG8_STAGE(PG8_SB(1, 1), cB + hsB + kstep, voffB);
    PG8_WAIT_V(6); PG8_BAR;
    for (;;) {
        const bool has_next = S.next(ui + 1, nxt);
        const char* nA = has_next ? PG8_UA(nxt) : cA; const char* nB = has_next ? PG8_UB(nxt) : cB;
        for (int t = 0; t < nt; t += 2) {
            const bool last = (t == nt - 2);
            const char* a1 = cA + (size_t)(t + 1) * kstep;
            const char* a2 = last ? nA : cA + (size_t)(t + 2) * kstep; const char* b2 = last ? nB : cB + (size_t)(t + 2) * kstep;
            const char* a3 = a2 + kstep; const char* b3 = b2 + kstep;
            PG8_LDB(B0, 0, 0); PG8_LDB(B1, 0, 1); PG8_SCHED; PG8_LDA(At, 0, 0); PG8_STAGE(PG8_SA(1, 1), a1 + hsA, voffA);
            PG8_WAIT_V(8); PG8_WAIT_L(0); PG8_BAR; PG8_MMA(0, 0, At, B0); PG8_MMA(0, 1, At, B1); PG8_BAR; PG8_SCHED;
            PG8_LDA(At, 0, 1); PG8_STAGE(PG8_SB(0, 0), b2, voffB); PG8_STAGE(PG8_SB(0, 1), b2 + hsB, voffB); PG8_STAGE(PG8_SA(0, 0), a2, voffA);
            PG8_WAIT_V(8); PG8_WAIT_L(0); PG8_BAR; PG8_MMA(1, 0, At, B0); PG8_MMA(1, 1, At, B1); PG8_BAR; PG8_SCHED;
            PG8_LDB(B0, 1, 0); PG8_LDB(B1, 1, 1); PG8_SCHED; PG8_LDA(At, 1, 0); PG8_STAGE(PG8_SA(0, 1), a2 + hsA, voffA);
            PG8_WAIT_V(8); PG8_WAIT_L(0); PG8_BAR; PG8_MMA(0, 0, At, B0); PG8_MMA(0, 1, At, B1); PG8_BAR; PG8_SCHED;
            PG8_LDA(At, 1, 1); PG8_STAGE(PG8_SB(1, 0), b3, voffB); PG8_STAGE(PG8_SB(1, 1), b3 + hsB, voffB); PG8_STAGE(PG8_SA(1, 0), a3, voffA);
            PG8_WAIT_V(8); PG8_WAIT_L(0); PG8_BAR; PG8_MMA(1, 0, At, B0); PG8_MMA(1, 1, At, B1); PG8_BAR; PG8_SCHED;
        }
        if (wr == 0) PG8_BAR;
        { int fr2 = fr, fq2 = fq; asm volatile("" : "+v"(fr2), "+v"(fq2)); E(acc, cur, wr, wc, fr2, fq2); }
        if (!has_next) break;
#pragma unroll
        for (int a = 0; a < 2; ++a)
#pragma unroll
            for (int b = 0; b < 2; ++b)
#pragma unroll
                for (int m = 0; m < 4; ++m)
#pragma unroll
                    for (int n = 0; n < 2; ++n) acc[a][b][m][n] = (f32x4){0.f, 0.f, 0.f, 0.f};
        cur = nxt; cA = nA; cB = nB; ++ui;
        if (wr == 1) PG8_BAR;
    }
    PG8_WAIT_V(0);
    PG8_BAR;
#undef PG8_UA
#undef PG8_UB
#undef PG8_SA
#undef PG8_SB
#undef PG8_STAGE
#undef PG8_LDA
#undef PG8_LDB
#undef PG8_MMA
#undef PG8_WAIT_V
#undef PG8_WAIT_L
#undef PG8_BAR
#undef PG8_SCHED
}
}

#include <hip/hip_bf16.h>
#include <cmath>
namespace attn_body {
using bf16=__hip_bfloat16;
using bf16x8=__attribute__((ext_vector_type(8)))short;
using s16x4=__attribute__((ext_vector_type(4)))short;
using f32x16=__attribute__((ext_vector_type(16)))float;
using u32x4=__attribute__((ext_vector_type(4)))unsigned;
using f32x4v=__attribute__((ext_vector_type(4)))float;
constexpr int BATCH=4,NHEAD=32,SEQ=4096,D=64,DM=NHEAD*D;
constexpr int NW=8,QBLK=32,QB=QBLK*NW,KVBLK=64,NQB=SEQ/QB;
constexpr int ATTN_PITCH=DM, ATTN_UNIT_ROWS=QB;
__device__ __forceinline__ int crow(int r,int hi){return (r&3)+8*(r>>2)+4*hi;}
#define SBAR() __builtin_amdgcn_sched_barrier(0)
__device__ __forceinline__ void cmask(f32x16&p0,f32x16&p1,int jb,int qrel,int hi){
  const float NEG=-INFINITY; int kb=64*jb+4*hi;
  #pragma unroll
  for(int r=0;r<16;++r){int kv=kb+(r&3)+8*(r>>2); if(kv>qrel)p0[r]=NEG; if(kv+32>qrel)p1[r]=NEG;}
}

constexpr int NSLOT=3, SLOTB=8192;
constexpr int LDS_K=0, LDS_V=NSLOT*SLOTB, LDS_WS=2*NSLOT*SLOTB, LDS_OST=LDS_WS+NW*64*4, LDS_NB=LDS_OST+NW*4096, LDS_WT=LDS_NB+SEQ*4, LDS_BYTES=LDS_WT+64;
constexpr float C2=0.125f*1.4426950408889634f;
__device__ __forceinline__ void glds16(const void*gsrc,unsigned lds_dst){unsigned keep;
  asm volatile("s_mov_b32 %0, m0\n\ts_mov_b32 m0, %2\n\ts_nop 0\n\tglobal_load_lds_dwordx4 %1, off\n\ts_mov_b32 m0, %0":"=&s"(keep):"v"(gsrc),"s"(lds_dst):"memory");}
__device__ __forceinline__ float max3f(float a,float b,float c){float r;asm("v_max3_f32 %0, %1, %2, %3":"=v"(r):"v"(a),"v"(b),"v"(c));return r;}
__device__ __forceinline__ float max2f(float a,float b){float r;asm("v_max_f32_e32 %0, %1, %2":"=v"(r):"v"(a),"v"(b));return r;}
__device__ __forceinline__ float fadd_s(float a,float b){float r;asm("v_add_f32_e32 %0, %1, %2":"=v"(r):"v"(a),"v"(b));return r;}
__device__ __forceinline__ float fsub_s(float a,float b){float r;asm("v_sub_f32_e32 %0, %1, %2":"=v"(r):"v"(a),"v"(b));return r;}
typedef float f32x2_t __attribute__((ext_vector_type(2))); typedef __bf16 bf16x2_t __attribute__((ext_vector_type(2)));
__device__ __forceinline__ unsigned cvtpk_s(float lo,float hi){f32x2_t v={lo,hi};bf16x2_t b=__builtin_convertvector(v,bf16x2_t);return __builtin_bit_cast(unsigned,b);}
#define WAIT_BAR(N) asm volatile("s_waitcnt vmcnt(" #N ") lgkmcnt(0)\n\ts_barrier":::"memory")

__device__ __forceinline__ void qkt(f32x16&p0,f32x16&p1,const char*Kslot,const bf16x8*qr,int r32,int hi){
  const char*kb=Kslot+hi*1024+r32*16;
  #pragma unroll
  for(int d0=0;d0<4;++d0){
    const bf16x8 b0=*reinterpret_cast<const bf16x8*>(kb+d0*2048);
    const bf16x8 b1=*reinterpret_cast<const bf16x8*>(kb+d0*2048+512);
    p0=__builtin_amdgcn_mfma_f32_32x32x16_bf16(b0,qr[d0],p0,0,0,0);p1=__builtin_amdgcn_mfma_f32_32x32x16_bf16(b1,qr[d0],p1,0,0,0);}
}
typedef __attribute__((address_space(3))) const char* lds_cptr;
typedef short v4i16_t __attribute__((ext_vector_type(4)));
__device__ __forceinline__ void kload8(bf16x8*kf,lds_cptr kp){
  kf[0]=*(const __attribute__((address_space(3))) bf16x8*)(kp);      kf[1]=*(const __attribute__((address_space(3))) bf16x8*)(kp+512);
  kf[2]=*(const __attribute__((address_space(3))) bf16x8*)(kp+2048); kf[3]=*(const __attribute__((address_space(3))) bf16x8*)(kp+2560);
  kf[4]=*(const __attribute__((address_space(3))) bf16x8*)(kp+4096); kf[5]=*(const __attribute__((address_space(3))) bf16x8*)(kp+4608);
  kf[6]=*(const __attribute__((address_space(3))) bf16x8*)(kp+6144); kf[7]=*(const __attribute__((address_space(3))) bf16x8*)(kp+6656);
}
__device__ __forceinline__ void kload2(bf16x8*kf,lds_cptr kp,int j){ kf[2*j]=*(const __attribute__((address_space(3))) bf16x8*)(kp+j*2048); kf[2*j+1]=*(const __attribute__((address_space(3))) bf16x8*)(kp+j*2048+512); }
__device__ __forceinline__ s16x4 vtr(lds_cptr p){ return __builtin_bit_cast(s16x4,__builtin_amdgcn_ds_read_tr16_b64_v4i16((__attribute__((address_space(3))) v4i16_t*)p)); }
__device__ __forceinline__ float rowmax(const f32x16&p0,const f32x16&p1){
  float a=max3f(p0[0],p0[1],p1[0]),b=max3f(p0[2],p0[3],p1[1]);a=max3f(a,p1[2],p1[3]);
  #pragma unroll
  for(int r=4;r<16;r+=4){a=max3f(a,p0[r],p0[r+1]);b=max3f(b,p0[r+2],p0[r+3]);a=max3f(a,p1[r],p1[r+1]);b=max3f(b,p1[r+2],p1[r+3]);}
  const float m=max2f(a,b);
  auto rr=__builtin_amdgcn_permlane32_swap(__float_as_uint(m),__float_as_uint(m),false,false);
  return max2f(__uint_as_float(rr[0]),__uint_as_float(rr[1]));
}
__device__ __forceinline__ void pv(f32x16*o,int vb,bf16x8 pa0,bf16x8 pa1,bf16x8 pa2,bf16x8 pa3){
  #pragma unroll
  for(int d0=0;d0<2;++d0){s16x4 lo[4],hi[4];
    #pragma unroll
    for(int ks=0;ks<4;++ks){
      asm volatile("ds_read_b64_tr_b16 %0,%1 offset:%c2":"=&v"(lo[ks]):"v"(vb),"i"(d0*4096+ks*1024):"memory");
      asm volatile("ds_read_b64_tr_b16 %0,%1 offset:%c2":"=&v"(hi[ks]):"v"(vb),"i"(d0*4096+ks*1024+512):"memory");}
    asm volatile("s_waitcnt lgkmcnt(0)":::"memory");SBAR();
    #define PK(k) (bf16x8){lo[k][0],lo[k][1],lo[k][2],lo[k][3],hi[k][0],hi[k][1],hi[k][2],hi[k][3]}
    o[d0]=__builtin_amdgcn_mfma_f32_32x32x16_bf16(pa0,PK(0),o[d0],0,0,0);
    o[d0]=__builtin_amdgcn_mfma_f32_32x32x16_bf16(pa1,PK(1),o[d0],0,0,0);
    o[d0]=__builtin_amdgcn_mfma_f32_32x32x16_bf16(pa2,PK(2),o[d0],0,0,0);
    o[d0]=__builtin_amdgcn_mfma_f32_32x32x16_bf16(pa3,PK(3),o[d0],0,0,0);
    #undef PK
  }
}

#ifndef ATTN_STORE16
#define ATTN_STORE16(p,v) (*(u32x4*)(p)=(v))
#endif
template<int THRL> __device__ __forceinline__ void attn_unit(int b,int h,int qb,int ts,const bf16*Q,const bf16*__restrict__ K,const bf16*__restrict__ V,bf16*O,const bf16*__restrict__ SG,char*shm,const int tid){
  const int lane=tid&63,r32=lane&31,hi=lane>>5; const int wid=__builtin_amdgcn_readfirstlane(tid>>6);
  const long rowbase=(long)b*SEQ; const int q0=qb*QB;
  const bf16*Qw=Q+(rowbase+q0+wid*QBLK)*DM+h*D;
  const bf16*Kh=K+(rowbase+(long)ts*KVBLK)*DM+h*D,*Vh=V+(rowbase+(long)ts*KVBLK)*DM+h*D;
  const lds_cptr shm3=(lds_cptr)shm;
  const unsigned lds0=(unsigned)(uintptr_t)shm;
  float*wsf=(float*)(shm+LDS_WS)+wid*64;
  const bf16*ksrc=Kh+(long)lane*DM+wid*8;
  const bf16*vsrc=Vh+(long)(16*(wid&3)+(lane>>2))*DM+(wid>>2)*32+(lane&3)*8;
  const unsigned kdst=lds0+LDS_K+wid*1024, vdst=lds0+LDS_V+wid*1024;
  #define DMA_K(t,slot) glds16(ksrc+(long)(t)*KVBLK*DM,(unsigned)__builtin_amdgcn_readfirstlane(kdst+(slot)))
  #define DMA_V(t,slot) glds16(vsrc+(long)(t)*KVBLK*DM,(unsigned)__builtin_amdgcn_readfirstlane(vdst+(slot)))
  const int vb0=(int)(lds0+LDS_V)+((lane>>4)&1)*32+(lane&3)*8+(4*hi+((lane&15)>>2))*64;
  const char*Kbase=shm+LDS_K; bf16x8 kf[8];
  const lds_cptr kp0=shm3+LDS_K+hi*1024+r32*16; const lds_cptr vp0=shm3+LDS_V+((lane>>4)&1)*32+(lane&3)*8+(4*hi+((lane&15)>>2))*64;
  const int NT=(q0+QB)/KVBLK-ts;
  DMA_K(0,0);DMA_V(0,0);DMA_K(1,SLOTB);
  bf16x8 qr[4];
  #pragma unroll
  for(int d0=0;d0<4;++d0)qr[d0]=*reinterpret_cast<const bf16x8*>(&Qw[(long)r32*DM+d0*16+hi*8]);
  float l_reg=0.f;f32x16 o[2];o[0]=f32x16{};o[1]=f32x16{};
  const int qrel=wid*QBLK+r32;
  typedef __attribute__((address_space(3))) const f32x4v* nb_ptr; const nb_ptr nbp0=(nb_ptr)(shm3+LDS_NB)+hi+ts*16;
  float negs=-((const __attribute__((address_space(3))) float*)(shm3+LDS_NB))[q0+qrel];
  #define CINIT(C0,C1,t) do{ const nb_ptr bp_=nbp0+(t)*16; _Pragma("unroll") for(int j_=0;j_<4;++j_){ const f32x4v a_=bp_[2*j_], b_=bp_[8+2*j_]; \
      C0[4*j_]=a_[0]+negs; C0[4*j_+1]=a_[1]+negs; C0[4*j_+2]=a_[2]+negs; C0[4*j_+3]=a_[3]+negs; \
      C1[4*j_]=b_[0]+negs; C1[4*j_+1]=b_[1]+negs; C1[4*j_+2]=b_[2]+negs; C1[4*j_+3]=b_[3]+negs; } }while(0)
  #define CMASK(P0,P1,t) do{int jb_=(t)-(NT-4); if(jb_>=0)cmask(P0,P1,jb_,qrel,hi);}while(0)
  bool resc=false;
  #define START(P0,P1) do{ const float rm=rowmax(P0,P1); resc=false; \
    if(__any(rm>(float)THRL)){ const float dl=__builtin_fmaxf(rm,0.f); negs-=dl; \
      _Pragma("unroll") for(int r=0;r<16;++r){P0[r]-=dl;P1[r]-=dl;} } \
    _Pragma("unroll") for(int r=0;r<16;++r)P0[r]=__builtin_amdgcn_exp2f(P0[r]); }while(0)
  #define RESC() do{ if(resc){ asm volatile("s_waitcnt lgkmcnt(0)":::"memory"); \
      _Pragma("unroll") for(int d_=0;d_<2;++d_) _Pragma("unroll") for(int r=0;r<16;++r)o[d_][r]*=wsf[crow(r,hi)]; } }while(0)
  f32x16 pA0,pA1,pB0,pB1;
  int sl_prev=0,sl_cur=0,sl_next=SLOTB;
  #define ROT() do{sl_prev=sl_cur;sl_cur=sl_next;sl_next=(sl_next==(NSLOT-1)*SLOTB)?0:sl_next+SLOTB;}while(0)
  DMA_K(2,2*SLOTB);
  WAIT_BAR(3);
  CINIT(pA0,pA1,0); qkt(pA0,pA1,Kbase,qr,r32,hi);asm volatile("s_nop 15\n\ts_nop 7":"+v"(pA0),"+v"(pA1));CMASK(pA0,pA1,0);
  START(pA0,pA1);
  _Pragma("unroll") for(int r=0;r<16;++r)pA1[r]=__builtin_amdgcn_exp2f(pA1[r]);
  WAIT_BAR(0);
  DMA_K(3,0);DMA_V(1,SLOTB);
  ROT();
  kload8(kf,kp0+sl_cur);
  WAIT_BAR(2);
  s16x4 vlo[8],vhi[8]; u32x4 pw0,pw1,pw2,pw3;
  #define PKW(P,B) cvtpk_s(P[B],P[B+1])
  #define PAF(k) __builtin_bit_cast(bf16x8,pw##k)
  #define VFR(i) (bf16x8){vlo[i][0],vlo[i][1],vlo[i][2],vlo[i][3],vhi[i][0],vhi[i][1],vhi[i][2],vhi[i][3]}
  #define PIN(x) asm volatile("":"+v"(x))
  #define MX3(a,b,c) __builtin_fmaxf(__builtin_fmaxf((a),(b)),(c))
  #define GAPA(MF,A0,A1,A2,A3,W0,W1,PW) do{ MF; sacc+=A0; sacc+=A1; sacc+=A2; sacc+=A3; PIN(sacc); W0; W1; PIN(PW); SBAR(); }while(0)
  #define EX(v) __builtin_amdgcn_exp2f(v)
  #define GAPB(MF,X,B) do{ MF; X[B]=EX(X[B]); X[B+1]=EX(X[B+1]); X[B+2]=EX(X[B+2]); X[B+3]=EX(X[B+3]); PIN(X); SBAR(); }while(0)
  #define VRD(i) do{ vlo[i]=vtr(vp_+(((i)>>2)*4096+((i)&3)*1024)); vhi[i]=vtr(vp_+(((i)>>2)*4096+((i)&3)*1024+512)); }while(0)
  #define KRD(G,j) do{ if(G){ kload2(kf,kp0+sl_next,j); SBAR(); } }while(0)
  #define STEP(C0,C1,P0,P1,t,GK,GV,GL) do{ SBAR(); CINIT(C0,C1,t); SBAR(); \
    const lds_cptr vp_=vp0+sl_prev; \
    VRD(0); SBAR(); float sacc=(P0[0]+P0[1]); \
    GAPA(C0=__builtin_amdgcn_mfma_f32_32x32x16_bf16(kf[0],qr[0],C0,0,0,0), P0[2],P0[3],P0[4],P0[5],     pw0[0]=PKW(P0,0), pw0[1]=PKW(P0,2), pw0); \
    VRD(4); SBAR(); GAPA(C1=__builtin_amdgcn_mfma_f32_32x32x16_bf16(kf[1],qr[0],C1,0,0,0), P0[6],P0[7],P0[8],P0[9],     pw0[2]=PKW(P0,4), pw0[3]=PKW(P0,6), pw0); \
    VRD(1); SBAR(); GAPA(C0=__builtin_amdgcn_mfma_f32_32x32x16_bf16(kf[2],qr[1],C0,0,0,0),   P0[10],P0[11],P0[12],P0[13], pw1[0]=PKW(P0,8), pw1[1]=PKW(P0,10), pw1); \
    VRD(5); SBAR(); GAPA(C1=__builtin_amdgcn_mfma_f32_32x32x16_bf16(kf[3],qr[1],C1,0,0,0),   P0[14],P0[15],P1[0],P1[1],   pw1[2]=PKW(P0,12),pw1[3]=PKW(P0,14), pw1); \
    VRD(2); SBAR(); GAPA(C0=__builtin_amdgcn_mfma_f32_32x32x16_bf16(kf[4],qr[2],C0,0,0,0),   P1[2],P1[3],P1[4],P1[5],     pw2[0]=PKW(P1,0), pw2[1]=PKW(P1,2), pw2); \
    VRD(6); SBAR(); GAPA(C1=__builtin_amdgcn_mfma_f32_32x32x16_bf16(kf[5],qr[2],C1,0,0,0),   P1[6],P1[7],P1[8],P1[9],     pw2[2]=PKW(P1,4), pw2[3]=PKW(P1,6), pw2); \
    VRD(3); SBAR(); GAPA(C0=__builtin_amdgcn_mfma_f32_32x32x16_bf16(kf[6],qr[3],C0,0,0,0),   P1[10],P1[11],P1[12],P1[13], pw3[0]=PKW(P1,8), pw3[1]=PKW(P1,10), pw3); \
    VRD(7); SBAR(); GAPA(C1=__builtin_amdgcn_mfma_f32_32x32x16_bf16(kf[7],qr[3],C1,0,0,0),   P1[14],P1[15],0.f,0.f,       pw3[2]=PKW(P1,12),pw3[3]=PKW(P1,14), pw3); \
    l_reg+=sacc; \
    if(GK){DMA_K((t)+3,sl_cur);} if(GV){DMA_V((t)+1,sl_next);} \
    CMASK(C0,C1,t); \
    { float a=MX3(C0[0],C0[1],C1[0]),b=MX3(C0[2],C0[3],C1[1]); a=MX3(a,C1[2],C1[3]); \
      _Pragma("unroll") for(int r=4;r<16;r+=4){a=MX3(a,C0[r],C0[r+1]);b=MX3(b,C0[r+2],C0[r+3]);a=MX3(a,C1[r],C1[r+1]);b=MX3(b,C1[r+2],C1[r+3]);} \
      float rm=__builtin_fmaxf(a,b); { auto rr=__builtin_amdgcn_permlane32_swap(__float_as_uint(rm),__float_as_uint(rm),false,false); rm=__builtin_fmaxf(__uint_as_float(rr[0]),__uint_as_float(rr[1])); } \
      resc=false; \
      if(__builtin_expect(__any(rm>(float)THRL),0)){ const float dl=__builtin_fmaxf(rm,0.f); \
        _Pragma("unroll") for(int r=0;r<16;++r){C0[r]-=dl;C1[r]-=dl;} \
        negs-=dl; \
        const float f=__builtin_amdgcn_exp2f(-dl); l_reg*=f; if(hi==0)wsf[r32]=f; resc=true; } } \
    SBAR(); \
    GAPB(o[0]=__builtin_amdgcn_mfma_f32_32x32x16_bf16(PAF(0),VFR(0),o[0],0,0,0), C0,0); \
    GAPB(o[1]=__builtin_amdgcn_mfma_f32_32x32x16_bf16(PAF(0),VFR(4),o[1],0,0,0), C0,4); \
    KRD(GL,0); GAPB(o[0]=__builtin_amdgcn_mfma_f32_32x32x16_bf16(PAF(1),VFR(1),o[0],0,0,0), C0,8); \
    KRD(GL,1); GAPB(o[1]=__builtin_amdgcn_mfma_f32_32x32x16_bf16(PAF(1),VFR(5),o[1],0,0,0), C0,12); \
    KRD(GL,2); GAPB(o[0]=__builtin_amdgcn_mfma_f32_32x32x16_bf16(PAF(2),VFR(2),o[0],0,0,0), C1,0); \
    KRD(GL,3); GAPB(o[1]=__builtin_amdgcn_mfma_f32_32x32x16_bf16(PAF(2),VFR(6),o[1],0,0,0), C1,4); \
    GAPB(o[0]=__builtin_amdgcn_mfma_f32_32x32x16_bf16(PAF(3),VFR(3),o[0],0,0,0), C1,8); \
    GAPB(o[1]=__builtin_amdgcn_mfma_f32_32x32x16_bf16(PAF(3),VFR(7),o[1],0,0,0), C1,12); \
    }while(0)
  int t=1;
  #undef CMASK
  #define CMASK(P0,P1,t) do{}while(0)
  for(;t+5<NT;t+=2){
    STEP(pB0,pB1,pA0,pA1,t,true,true,true);     WAIT_BAR(2); RESC(); ROT();
    STEP(pA0,pA1,pB0,pB1,t+1,true,true,true);   WAIT_BAR(2); RESC(); ROT();
  }
  #undef CMASK
  #define CMASK(P0,P1,t) do{int jb_=(t)-(NT-4); if(jb_>=0)cmask(P0,P1,jb_,qrel,hi);}while(0)
  #define ENDW(tt) do{ if((tt)+3<NT){WAIT_BAR(2);} else if((tt)+2<NT){WAIT_BAR(1);} else {WAIT_BAR(0);} }while(0)
  for(;t+1<NT;t+=2){
    STEP(pB0,pB1,pA0,pA1,t,(t+3<NT),(t+1<NT),(t+1<NT));       ENDW(t);   RESC(); ROT();
    STEP(pA0,pA1,pB0,pB1,t+1,(t+4<NT),(t+2<NT),(t+2<NT));     ENDW(t+1); RESC(); ROT();
  }
  STEP(pB0,pB1,pA0,pA1,NT-1,false,false,false); RESC();
  { float sacc=pB0[0]+pB0[1]; _Pragma("unroll") for(int r=2;r<16;++r)sacc+=pB0[r]; _Pragma("unroll") for(int r=0;r<16;++r)sacc+=pB1[r]; l_reg+=sacc;
    pw0=(u32x4){PKW(pB0,0),PKW(pB0,2),PKW(pB0,4),PKW(pB0,6)};pw1=(u32x4){PKW(pB0,8),PKW(pB0,10),PKW(pB0,12),PKW(pB0,14)};pw2=(u32x4){PKW(pB1,0),PKW(pB1,2),PKW(pB1,4),PKW(pB1,6)};pw3=(u32x4){PKW(pB1,8),PKW(pB1,10),PKW(pB1,12),PKW(pB1,14)};
    SBAR(); pv(o,vb0+sl_cur,PAF(0),PAF(1),PAF(2),PAF(3)); }
  #undef PKW
  #undef PAF
  #undef VFR
  #undef PIN
  #undef MX3
  #undef GAPA
  #undef GAPB
  #undef EX
  #undef VRD
  #undef KRD
  #undef STEP
  #undef ENDW
  {auto rr=__builtin_amdgcn_permlane32_swap(__float_as_uint(l_reg),__float_as_uint(l_reg),false,false);l_reg=__uint_as_float(rr[0])+__uint_as_float(rr[1]);}
  if(hi==0)wsf[32+r32]=l_reg;asm volatile("s_waitcnt lgkmcnt(0)":::"memory");
  float rli[16];
  #pragma unroll
  for(int r=0;r<16;++r)rli[r]=__builtin_amdgcn_rcpf(wsf[32+crow(r,hi)]);
  bf16*Ow=O+(rowbase+q0+wid*QBLK)*DM+h*D; const bf16*Gw=SG+(rowbase+q0+wid*QBLK)*DM+h*D;
  { bf16*stg=(bf16*)(shm+LDS_OST)+wid*2048;
    #pragma unroll
    for(int r=0;r<16;++r){const int orow=crow(r,hi);
      #pragma unroll
      for(int d0=0;d0<2;++d0)stg[orow*64+d0*32+r32]=__float2bfloat16(o[d0][r]*rli[r]);}
    asm volatile("s_waitcnt lgkmcnt(0)":::"memory");
    #pragma unroll
    for(int i=0;i<4;++i){const int row=i*8+(lane>>3),ch=lane&7; u32x4 v=*(const u32x4*)(stg+row*64+ch*8); const u32x4 gv=*(const u32x4*)(Gw+(long)row*DM+ch*8);
      #pragma unroll
      for(int e=0;e<4;++e){ const float a0=__uint_as_float(v[e]<<16),a1=__uint_as_float(v[e]&0xffff0000u),g0=__uint_as_float(gv[e]<<16),g1=__uint_as_float(gv[e]&0xffff0000u); v[e]=cvtpk_s(a0*g0,a1*g1); }
      ATTN_STORE16(Ow+(long)row*DM+ch*8,v);} }
  asm volatile("s_waitcnt lgkmcnt(0)\n\ts_barrier":::"memory");
  #undef DMA_K
  #undef DMA_V
  #undef CMASK
  #undef CINIT
  #undef START
  #undef RESC
  #undef ROT
}
constexpr int ATTN_LDS_BYTES=LDS_BYTES;
struct AttnTensors { const bf16* Q; const bf16* K; const bf16* V; bf16* O; const bf16* SG; const float* logf; };
__device__ __forceinline__ void fox_scan(char*shm,const float*__restrict__ logf,int bh,const int tid,float*__restrict__ nbout){
  const int lane=tid&63,wid=tid>>6; const int b=bh/NHEAD,h=bh%NHEAD;
  const float*src=logf+((long)b*SEQ+(long)tid*8)*NHEAD+h; float v[8];
  #pragma unroll
  for(int i=0;i<8;++i)v[i]=src[i*NHEAD];
  #pragma unroll
  for(int i=1;i<8;++i)v[i]+=v[i-1];
  const float tot=v[7]; float sc=tot;
  #pragma unroll
  for(int off=1;off<64;off<<=1){const float o_=__shfl_up(sc,off); if(lane>=off)sc+=o_;}
  float*wt=(float*)(shm+LDS_WT);
  __syncthreads();
  if(lane==63)wt[wid]=sc;
  __syncthreads();
  float woff=0.f;
  #pragma unroll
  for(int w=0;w<8;++w)woff+=(w<wid)?wt[w]:0.f;
  const float excl=woff+sc-tot;
  f32x4v o0,o1; o0[0]=-(excl+v[0])*1.4426950408889634f; o0[1]=-(excl+v[1])*1.4426950408889634f; o0[2]=-(excl+v[2])*1.4426950408889634f; o0[3]=-(excl+v[3])*1.4426950408889634f;
  o1[0]=-(excl+v[4])*1.4426950408889634f; o1[1]=-(excl+v[5])*1.4426950408889634f; o1[2]=-(excl+v[6])*1.4426950408889634f; o1[3]=-(excl+v[7])*1.4426950408889634f;
  f32x4v*dst=(f32x4v*)(nbout+(long)bh*SEQ+tid*8); dst[0]=o0; dst[1]=o1;
  __syncthreads();
}
template<int THRL=8> __device__ __forceinline__ void attn_phase(char*lds,const AttnTensors&T,const int tid0,unsigned*counter,const float*__restrict__ nbg,float thr){
  volatile unsigned*wq=(volatile unsigned*)(lds+LDS_WT)+8;
  unsigned unext=0u; if(tid0==0)unext=__hip_atomic_fetch_add(counter,1u,__ATOMIC_RELAXED,__HIP_MEMORY_SCOPE_AGENT);
  for(;;){
    if(tid0==0)*wq=unext;
    __syncthreads();
    const unsigned u=*wq;
    if(u>=(unsigned)(BATCH*NHEAD*NQB))break;
    if(tid0==0)unext=__hip_atomic_fetch_add(counter,1u,__ATOMIC_RELAXED,__HIP_MEMORY_SCOPE_AGENT);
    const int qb=NQB-1-(int)(u/(BATCH*NHEAD)), bh=(int)(u%(BATCH*NHEAD));
    { const f32x4v*src=(const f32x4v*)(nbg+(long)bh*SEQ); f32x4v*dst=(f32x4v*)(lds+LDS_NB); const int n4=(qb+1)*(QB/4); for(int i=tid0;i<n4;i+=NW*64)dst[i]=src[i]; }
    __syncthreads();
    const float*nb=(const float*)(lds+LDS_NB); const int NT0=(QB/KVBLK)*(qb+1); const float ref=nb[qb*QB]-thr;
    int lo=0,hi=NT0; while(lo<hi){ const int mid=(lo+hi)>>1; if(nb[KVBLK*mid+KVBLK-1]<ref)lo=mid+1; else hi=mid; }
    int ts=lo&~1; if(ts>NT0-4)ts=NT0-4;
    int tid=tid0; asm volatile("":"+v"(tid));
    attn_unit<THRL>(bh/NHEAD,bh%NHEAD,qb,ts,T.Q,T.K,T.V,T.O,T.SG,lds,tid);
  }
}
#undef SBAR
#undef WAIT_BAR
}

constexpr size_t MiB = 1u << 20;
constexpr size_t WS_SSQ = 65536;
constexpr size_t WS_LOGF = 2 * MiB;
constexpr size_t WS_WPOOL = 4 * MiB, WPOOL_L = 2 * MiB;
constexpr size_t WS_WOUT = 8 * MiB, WOUT_L = 8 * MiB;
constexpr size_t WS_WIN = 24 * MiB, WIN_L = 33 * MiB;
constexpr size_t WS_WD = 90 * MiB, WD_L = 22 * MiB;
constexpr size_t WS_WGU = 178 * MiB, WGU_L = 44 * MiB;
constexpr size_t WS_HB = 354 * MiB;
constexpr size_t WS_Q = 418 * MiB, ACT_MD = 64 * MiB;
constexpr size_t WS_ACT = 674 * MiB;
constexpr size_t WS_NBG = 850 * MiB;
constexpr size_t WS_END = 852 * MiB;
constexpr size_t CTL_ATTN_CNT = 14336;
static_assert((size_t)NIN_PAD * DM * 2 == WIN_L && (size_t)DM * FF * 2 == WD_L && (size_t)NGU * DM * 2 == WGU_L && (size_t)M * DM * 2 == ACT_MD && (size_t)M * FF * 2 == 176 * MiB, "ws map");

#ifndef SKEW_US
#define SKEW_US 0
#endif
#ifndef PROBE_DUP
#define PROBE_DUP 0
#endif
constexpr int LDS_BYTES = 147456;
constexpr int NWAVES = 8;
static_assert(attn_body::LDS_BYTES <= 131072, "attention LDS");

#define LAS __attribute__((address_space(3)))
typedef unsigned short bf16;
typedef unsigned v4u __attribute__((ext_vector_type(4)));
typedef unsigned v2u __attribute__((ext_vector_type(2)));
typedef float f32x4 __attribute__((ext_vector_type(4)));
#define LDS_WAIT() asm volatile("s_waitcnt lgkmcnt(0)" ::: "memory")
__device__ __forceinline__ unsigned pk2(float lo, float hi) { return pg8::cvt_pk_bf16(lo, hi); }
__device__ __forceinline__ float wave_sum(float v) {
#pragma unroll
    for (int o = 1; o < 64; o <<= 1) v += __shfl_xor(v, o);
    return v;
}

__device__ __forceinline__ int map_row_gu(int n) { const int j = n < FF ? n : n - FF; return (j >> 7) * 256 + (n < FF ? 0 : 128) + (j & 127); }
__device__ __forceinline__ int map_row_in(int n) { if (n >= 4 * DM) return n; const int t = n >> 11, r = n & 2047, head = r >> 6, d = r & 63; return (t * 8 + (head >> 2)) * 256 + (d >> 5) * 128 + (head & 3) * 32 + (d & 31); }
template <int MAP> __device__ __forceinline__ void tr_item(const float* __restrict__ W, int K, int N, bf16* __restrict__ WT, const float* __restrict__ gain, LAS float* scr, int kb, int nb, int lane) {
    const int k0 = kb * 64, n0 = nb * 64, n4 = lane & 15, kr = lane >> 4;
    const bool nok = (n0 + 4 * n4) < N;
#pragma unroll 8
    for (int i = 0; i < 16; ++i) { const int kk = 4 * i + kr; f32x4 v = (f32x4){0.f, 0.f, 0.f, 0.f};
        if (nok) v = *(const f32x4*)(W + (size_t)(k0 + kk) * N + n0 + 4 * n4);
        if (gain) v = v * gain[k0 + kk];
        LAS float* s = scr + kk * 65 + 4 * n4; s[0] = v[0]; s[1] = v[1]; s[2] = v[2]; s[3] = v[3]; }
    LDS_WAIT();
    const int c = lane & 7;
#pragma unroll
    for (int j = 0; j < 8; ++j) { const int n = (lane >> 3) + 8 * j;
        if (n0 + n < N) { const LAS float* s = scr + (8 * c) * 65 + n;
            v4u o; o.x = pk2(s[0 * 65], s[1 * 65]); o.y = pk2(s[2 * 65], s[3 * 65]); o.z = pk2(s[4 * 65], s[5 * 65]); o.w = pk2(s[6 * 65], s[7 * 65]);
            const int nn = n0 + n; const int row = MAP == 1 ? map_row_gu(nn) : (MAP == 2 ? map_row_in(nn) : nn);
            *(v4u*)(WT + (size_t)row * K + k0 + 8 * c) = o; } }
    LDS_WAIT();
}

constexpr size_t WS_CTL = 0, CTL_ZERO_BYTES = 16384;
constexpr int MISC_OFF = LDS_BYTES - 64;
#define GAS __attribute__((address_space(1)))
typedef GAS unsigned gu32;
typedef GAS unsigned long long gu64;
#define RLX_AGENT __ATOMIC_RELAXED, __HIP_MEMORY_SCOPE_AGENT
#define VM_WAIT() asm volatile("s_waitcnt vmcnt(0)" ::: "memory")
__device__ __forceinline__ unsigned long long rt() { return __builtin_amdgcn_s_memrealtime(); }
#define XB_TMO      128
#define XB_XCNT(j)  (256  + 64 * (j))
#define XB_XSUB(j)  (1280 + 64 * (j))
#define XB_XGEN(j)  (2304 + 64 * (j))
#define XB_TOP      3328
#define XB_TOPGEN   3392
#define XCD_BAR_WORDS 3456
#define XB_SPIN_CAP (1u << 18)

__device__ __forceinline__ unsigned xb_ld(unsigned* p)              { return __hip_atomic_load(p, __ATOMIC_RELAXED, __HIP_MEMORY_SCOPE_AGENT); }
__device__ __forceinline__ unsigned xb_add(unsigned* p, unsigned v) { return __hip_atomic_fetch_add(p, v, __ATOMIC_RELAXED, __HIP_MEMORY_SCOPE_AGENT); }
__device__ __forceinline__ unsigned xb_xcc_id() { return (unsigned)__builtin_amdgcn_s_getreg((3 << 11) | 20) & 0xFu; }
#define XB_SPIN(cond, bar) do { unsigned _sp = 0; while (cond) { __builtin_amdgcn_s_sleep(1); \
    if ((++_sp & 255u) == 0u) { if (xb_ld(&(bar)[XB_TMO])) break; if (_sp > XB_SPIN_CAP) { atomicAdd(&(bar)[XB_TMO], 1u); break; } } } } while (0)

struct XcdBarrier {
    unsigned* bar; unsigned x;
    volatile LAS unsigned* st;
};

__device__ __forceinline__ XcdBarrier xcd_barrier_post(unsigned* bar, volatile LAS unsigned* st) {
    XcdBarrier b; b.bar = bar; b.x = xb_xcc_id(); b.st = st;
    if (threadIdx.x == 0) (void)xb_add(&bar[XB_XCNT(b.x)], 1u);
    return b;
}
__device__ __forceinline__ void xcd_barrier_complete(unsigned* bar, unsigned x, unsigned& nloc, unsigned& nx) {
    const unsigned G = gridDim.x * gridDim.y * gridDim.z;
    unsigned sum, cnt, mine, sp = 0u;
    for (;;) {
        sum = 0u; cnt = 0u; mine = 0u;
#pragma unroll
        for (unsigned j = 0; j < 16; ++j) { const unsigned c = xb_ld(&bar[XB_XCNT(j)]); sum += c; cnt += (c > 0u) ? 1u : 0u; mine = (j == x) ? c : mine; }
        if (sum == G) break;
        __builtin_amdgcn_s_sleep(1);
        if ((++sp & 255u) == 0u) { if (xb_ld(&bar[XB_TMO])) break; if (sp > XB_SPIN_CAP) { atomicAdd(&bar[XB_TMO], 1u); break; } }
    }
    nloc = mine > 0u ? mine : 1u; nx = cnt > 0u ? cnt : 1u;
}

__device__ __forceinline__ void xcd_barrier(const XcdBarrier& b) {
    asm volatile("s_waitcnt vmcnt(0)" ::: "memory");
    __syncthreads();
    if (threadIdx.x == 0) {
        unsigned* bar = b.bar;
        __builtin_amdgcn_s_waitcnt(0);
        unsigned nloc = b.st[0], nx = b.st[1];
        if (nloc == 0u) { xcd_barrier_complete(bar, b.x, nloc, nx); b.st[0] = nloc; b.st[1] = nx; }
        const unsigned old = xb_add(&bar[XB_XSUB(b.x)], 1u);
        const unsigned gen = old / nloc;
        if (old + 1u == (gen + 1u) * nloc) {
            __builtin_amdgcn_fence(__ATOMIC_RELEASE, "agent");
            asm volatile("s_waitcnt vmcnt(0)" ::: "memory");
            const unsigned og = xb_add(&bar[XB_TOP], 1u);
            const unsigned tg = og / nx;
            if (og + 1u == (tg + 1u) * nx) xb_add(&bar[XB_TOPGEN], 1u);
            else XB_SPIN(xb_ld(&bar[XB_TOPGEN]) == tg, bar);
            __builtin_amdgcn_fence(__ATOMIC_ACQUIRE, "agent");
            xb_add(&bar[XB_XGEN(b.x)], 1u);
            asm volatile("s_waitcnt vmcnt(0)" ::: "memory");
        } else {
            XB_SPIN(xb_ld(&bar[XB_XGEN(b.x)]) == gen, bar);
            __builtin_amdgcn_fence(__ATOMIC_ACQUIRE, "agent");
            asm volatile("s_waitcnt vmcnt(0)" ::: "memory");
        }
    }
    __syncthreads();
}

struct Args { const float* in[15]; int ph_lo, ph_hi; };

constexpr int NPHASE = 20;
__device__ __forceinline__ void phase_info(int ph, int& type, int& layer) {
    if (ph == 0) { type = 0; layer = 0; return; }
    if (ph == NPHASE - 1) { type = 8; layer = 0; return; }
    int p = ph - 1; int l = 0;
    if (p >= 4) { p -= 4; l = 1; if (p >= 5) { p -= 5; l = 2; if (p >= 4) { p -= 4; l = 3; } } }
    layer = l;
    if ((l & 1) == 0) type = (p == 0) ? 1 : (p == 1) ? 2 : (p == 2) ? 3 : 4;
    else type = (p == 0) ? 5 : (p == 1) ? 6 : (p == 2) ? 7 : (p == 3) ? 3 : 4;
}

__global__ void __launch_bounds__(NWAVES * 64, 2) fwd_kernel(Args args) {
    extern __shared__ __attribute__((aligned(16))) unsigned char lds[];
    cg::grid_group grid = cg::this_grid();
    LAS unsigned char* ldsl = (LAS unsigned char*)lds;
    volatile LAS unsigned* MISC = (volatile LAS unsigned*)(ldsl + MISC_OFF);
    if (threadIdx.x < 16) MISC[threadIdx.x] = 0u;
    __syncthreads();
    XcdBarrier bar = xcd_barrier_post((unsigned*)((unsigned char*)args.in[14] + WS_CTL), MISC);

    for (int ph = args.ph_lo; ph < args.ph_hi; ++ph) {
        int php = ph; bool dry = false;
        if (PROBE_DUP >> 1) { int cnt = 0; for (php = 0; php < NPHASE; ++php) { const int n = 1 + (((PROBE_DUP >> 1) >> php) & 1); if (ph < cnt + n) { dry = (n == 2 && ph == cnt); break; } cnt += n; } }
        int type, layer; phase_info(php, type, layer);
        int tid = threadIdx.x; asm volatile("" : "+v"(tid)); int bx = blockIdx.x; asm volatile("" : "+s"(bx)); int G = gridDim.x; asm volatile("" : "+s"(G));
        const int lane = tid & 63, wave = __builtin_amdgcn_readfirstlane(tid >> 6);
        const int vcu = (G % 8 == 0) ? (bx % 8) * (G / 8) + bx / 8 : bx;
        const int j2 = layer >> 1;
        int z = 0; asm volatile("" : "+s"(z));
        unsigned char* ws = (unsigned char*)args.in[14 + z];
        const float* x = args.in[0 + z]; const float* attn_g = args.in[1 + z]; const float* ffn_g = args.in[2 + z]; const float* final_g = args.in[3 + z];
        const float* pool_w = args.in[4 + z]; const float* pool_scale = args.in[5 + z]; const float* w_in = args.in[6 + z]; const float* b_f = args.in[7 + z];
        const float* qn_g = args.in[8 + z]; const float* kn_g = args.in[9 + z]; const float* w_out = args.in[10 + z]; const float* w_gu = args.in[11 + z]; const float* w_dn = args.in[12 + z];
        float* H = (float*)args.in[13 + z];
        pg8::ssq_t* SSQ = (pg8::ssq_t*)(ws + WS_SSQ); float* LOGF = (float*)(ws + WS_LOGF);
        bf16* HB = (bf16*)(ws + WS_HB); bf16* QB = (bf16*)(ws + WS_Q); bf16* ACT = (bf16*)(ws + WS_ACT);
        if (SKEW_US > 0 && (type == 2 || type == 4 || type == 7)) {
            const unsigned long long t0 = __builtin_amdgcn_s_memrealtime(), dt = (unsigned long long)((vcu & 3) * SKEW_US * 100);
            while (__builtin_amdgcn_s_memrealtime() - t0 < dt) __builtin_amdgcn_s_sleep(16);
        }
        switch (type) {
        case 0: {
            LAS float* scr = (LAS float*)(ldsl + wave * 16640);
            const int gw = vcu * NWAVES + wave, NGW = G * NWAVES;
            constexpr int I_GU = 32 * 176, I_DN = 88 * 32, I_IN = 32 * 129, I_OUT = 32 * 32, I_PL = 8 * 8;
            constexpr int T_GU = 4 * I_GU, T_DN = 4 * I_DN, T_IN = 2 * I_IN, T_OUT = 2 * I_OUT, T_PL = 8 * I_PL;
            for (int it = gw; it < T_GU + T_DN + T_IN + T_OUT + T_PL; it += NGW) {
                int r = it;
                if (r < T_GU) { const int l = r / I_GU; r %= I_GU; tr_item<1>(w_gu + (size_t)l * DM * NGU, DM, NGU, (bf16*)(ws + WS_WGU + l * WGU_L), ffn_g + l * DM, scr, (r / (8 * 176)) * 8 + (r & 7), (r % (8 * 176)) >> 3, lane); continue; } r -= T_GU;
                if (r < T_DN) { const int l = r / I_DN; r %= I_DN; tr_item<0>(w_dn + (size_t)l * FF * DM, FF, DM, (bf16*)(ws + WS_WD + l * WD_L), nullptr, scr, (r / (8 * 32)) * 8 + (r & 7), (r % (8 * 32)) >> 3, lane); continue; } r -= T_DN;
                if (r < T_IN) { const int l = r / I_IN; r %= I_IN; tr_item<2>(w_in + (size_t)l * DM * NIN, DM, NIN, (bf16*)(ws + WS_WIN + l * WIN_L), attn_g + (2 * l + 1) * DM, scr, (r / (8 * 129)) * 8 + (r & 7), (r % (8 * 129)) >> 3, lane); continue; } r -= T_IN;
                if (r < T_OUT) { const int l = r / I_OUT; r %= I_OUT; tr_item<0>(w_out + (size_t)l * DM * DM, DM, DM, (bf16*)(ws + WS_WOUT + l * WOUT_L), nullptr, scr, (r / (8 * 32)) * 8 + (r & 7), (r % (8 * 32)) >> 3, lane); continue; } r -= T_OUT;
                { const int lg = r / I_PL; r %= I_PL; tr_item<0>(pool_w + (size_t)lg * PG * PG, PG, PG, (bf16*)(ws + WS_WPOOL) + (size_t)lg * PG * PG, nullptr, scr, (r / (8 * 8)) * 8 + (r & 7), (r % (8 * 8)) >> 3, lane); }
            }
            for (int m = gw; m < M; m += NGW) {
                const f32x4* xr = (const f32x4*)(x + (size_t)m * DM) + lane; float s = 0.f; f32x4 v[8];
#pragma unroll
                for (int j = 0; j < 8; ++j) { v[j] = xr[64 * j]; const f32x4 q = v[j] * v[j]; s += (q[0] + q[1]) + (q[2] + q[3]); }
                s = wave_sum(s);
                v2u* o8 = (v2u*)(HB + (size_t)m * DM) + lane;
#pragma unroll
                for (int j = 0; j < 8; ++j) { v2u w; w.x = pk2(v[j][0], v[j][1]); w.y = pk2(v[j][2], v[j][3]); o8[64 * j] = w; }
                if (lane == 0) SSQ[m] = (pg8::ssq_t)(s * pg8::SSQ_SCALE);
            }
            for (int i = bx * (NWAVES * 64) + tid; i < 8 * M; i += G * NWAVES * 64) SSQ[M + i] = 0ull;
        } break;
        case 1: {
            const pg8::ssq_t* ssq = SSQ + (size_t)(2 * layer) * M;
            const int tl = tid & 255, c8 = tl * 8, win = 2 << (tl >> 6), half = tid >> 8;
            const f32x4 ga = *(const f32x4*)(attn_g + layer * DM + c8), gb = *(const f32x4*)(attn_g + layer * DM + c8 + 4);
#define HN_ROW(r, lo, hi) do { const v4u w_ = *(const v4u*)(HB + (size_t)(r) * DM + c8); const float rs_ = pg8::rstd_row(ssq, (r)); \
                lo = (f32x4){__uint_as_float(w_.x << 16), __uint_as_float(w_.x & 0xffff0000u), __uint_as_float(w_.y << 16), __uint_as_float(w_.y & 0xffff0000u)} * rs_; \
                hi = (f32x4){__uint_as_float(w_.z << 16), __uint_as_float(w_.z & 0xffff0000u), __uint_as_float(w_.w << 16), __uint_as_float(w_.w & 0xffff0000u)} * rs_; } while (0)
            for (int ch = vcu; ch < M / 64; ch += G) {
                const int t0 = ch * 64 + half * 32, tp0 = t0 & (SEQ - 1);
                f32x4 sa = (f32x4){0.f, 0.f, 0.f, 0.f}, sb = sa, va, vb;
                for (int j = 1; j < win; ++j) if (tp0 - j >= 0) { HN_ROW(t0 - j, va, vb); sa += va; sb += vb; }
                sa = sa * ga; sb = sb * gb;
#pragma unroll 8
                for (int i = 0; i < 32; ++i) { const int r = t0 + i;
                    HN_ROW(r, va, vb); va = va * ga; vb = vb * gb;
                    sa += va; sb += vb; const float ic = 1.0f / (float)min(tp0 + i + 1, win); const f32x4 fa = sa * ic - va, fb = sb * ic - vb;
                    v4u w; w.x = pk2(fa[0], fa[1]); w.y = pk2(fa[2], fa[3]); w.z = pk2(fb[0], fb[1]); w.w = pk2(fb[2], fb[3]); *(v4u*)(QB + (size_t)r * DM + c8) = w;
                    if (tp0 + i - (win - 1) >= 0) { f32x4 oa, ob; HN_ROW(r - (win - 1), oa, ob); sa -= oa * ga; sb -= ob * gb; } }
            }
#undef HN_ROW
        } break;
        case 2: {
            pg8::Gemm g{QB, (const bf16*)(ws + WS_WPOOL + j2 * WPOOL_L), M, DM, PG, DM, 2}; pg8::StaticOrder S; S.init(M, DM, G, bx);
            pg8::EpiResid<true, false> E{HB, nullptr, SSQ + (size_t)(2 * layer + 1) * M, pool_scale + j2 * DM};
            pg8::gemm_phase<pg8::EpiResid<true, false>>(ldsl, g, S, E, tid);
        } break;
        case 3: {
            pg8::Gemm g{HB, (const bf16*)(ws + WS_WGU + layer * WGU_L), M, NGU, DM, DM, 1 << 20}; pg8::StaticOrder S; S.init(M, NGU, G, bx);
            pg8::EpiSwiglu E{ACT, SSQ + (size_t)(2 * layer + 1) * M};
            pg8::gemm_phase<pg8::EpiSwiglu>(ldsl, g, S, E, tid);
        } break;
        case 4: case 7: {
            pg8::Gemm g{ACT, (type == 4) ? (const bf16*)(ws + WS_WD + layer * WD_L) : (const bf16*)(ws + WS_WOUT + j2 * WOUT_L), M, DM, (type == 4) ? FF : DM, (type == 4) ? FF : DM, 1 << 20};
            pg8::StaticOrder S; S.init(M, DM, G, bx);
            pg8::EpiResid<false, false> E{HB, nullptr, SSQ + (size_t)(2 * layer + ((type == 4) ? 2 : 1)) * M, nullptr};
            pg8::gemm_phase<pg8::EpiResid<false, false>>(ldsl, g, S, E, tid);
        } break;
        case 5: {
            pg8::Gemm g{HB, (const bf16*)(ws + WS_WIN + j2 * WIN_L), M, 4 * DM, DM, DM, 1 << 20}; pg8::StaticOrder S; S.init(M, 4 * DM, G, bx);
            pg8::EpiFoxIn E{QB, (size_t)M * DM, LOGF, SSQ + (size_t)(2 * layer) * M, b_f + j2 * NH, qn_g + j2 * HD, kn_g + j2 * HD, attn_body::C2};
            pg8::gemm_phase<pg8::EpiFoxIn>(ldsl, g, S, E, tid);
            {
                typedef float f32x16 __attribute__((ext_vector_type(16))); typedef short bf16x8v __attribute__((ext_vector_type(8)));
                const int r32 = lane & 31, hi = lane >> 5; const bf16* Wf = (const bf16*)(ws + WS_WIN + j2 * WIN_L) + (size_t)(4 * DM) * DM;
                const pg8::ssq_t* ssq = SSQ + (size_t)(2 * layer) * M; LAS float* red = (LAS float*)ldsl;
                for (int rb = vcu; rb < M / 64; rb += G) {
                    f32x16 d0 = {}, d1 = {};
                    const bf16* a0p = HB + (size_t)(rb * 64 + r32) * DM + wave * 256 + 8 * hi; const bf16* bp = Wf + (size_t)r32 * DM + wave * 256 + 8 * hi;
#pragma unroll 8
                    for (int ks = 0; ks < 16; ++ks) { const bf16x8v a0 = *(const bf16x8v*)(a0p + ks * 16), a1 = *(const bf16x8v*)(a0p + (size_t)32 * DM + ks * 16), b = *(const bf16x8v*)(bp + ks * 16);
                        d0 = __builtin_amdgcn_mfma_f32_32x32x16_bf16(a0, b, d0, 0, 0, 0); d1 = __builtin_amdgcn_mfma_f32_32x32x16_bf16(a1, b, d1, 0, 0, 0); }
#pragma unroll
                    for (int r = 0; r < 16; ++r) { red[((wave * 2 + 0) * 16 + r) * 64 + lane] = d0[r]; red[((wave * 2 + 1) * 16 + r) * 64 + lane] = d1[r]; }
                    __syncthreads();
                    { const int blk = tid >> 8, l2 = tid & 63, q4 = (tid >> 6) & 3, j = l2 & 31, h2 = l2 >> 5; const float bias = b_f[j2 * NH + j];
#pragma unroll
                      for (int rr = 0; rr < 4; ++rr) { const int r = 4 * q4 + rr; float s = 0.f;
#pragma unroll
                          for (int w = 0; w < 8; ++w) s += red[((w * 2 + blk) * 16 + r) * 64 + l2];
                          const int row = rb * 64 + blk * 32 + (r & 3) + 8 * (r >> 2) + 4 * h2;
                          const float zv = s * pg8::rstd_row(ssq, row) + bias;
                          LOGF[(size_t)row * NH + j] = fminf(zv, 0.f) - __logf(1.0f + __expf(-fabsf(zv))); } }
                    __syncthreads();
                }
            }
        } break;
        case 6: {
            const attn_body::AttnTensors AT{(const attn_body::bf16*)QB, (const attn_body::bf16*)(QB + (size_t)M * DM), (const attn_body::bf16*)(QB + 2 * (size_t)M * DM), (attn_body::bf16*)ACT,
                                            (const attn_body::bf16*)(QB + 3 * (size_t)M * DM), LOGF};
            float* NBG = (float*)(ws + WS_NBG);
            for (int bh = vcu; bh < BATCH * NH; bh += G) attn_body::fox_scan((char*)lds, LOGF, bh, tid, NBG);
            asm volatile("s_waitcnt vmcnt(0) lgkmcnt(0)" ::: "memory"); xcd_barrier(bar);
            float gqm = 0.f, gkm = 0.f;
            for (int i = 0; i < HD; ++i) { gqm = fmaxf(gqm, fabsf(qn_g[j2 * HD + i])); gkm = fmaxf(gkm, fabsf(kn_g[j2 * HD + i])); }
            const float thr = 2.0f * (8.0f * gqm * gkm * 1.4426950408889634f * 1.02f) + 40.0f;
            attn_body::attn_phase<8>((char*)lds, AT, tid, (unsigned*)(ws + WS_CTL + CTL_ATTN_CNT + j2 * 256), NBG, thr);
        } break;
        default: {
            const pg8::ssq_t* ssq = SSQ + (size_t)8 * M; const int gw = vcu * NWAVES + wave, NGW = G * NWAVES;
            for (int m = gw; m < M; m += NGW) { const float rs = pg8::rstd_row(ssq, m); f32x4* hr = (f32x4*)(H + (size_t)m * DM) + lane; const f32x4* gr = (const f32x4*)final_g + lane; const v2u* br = (const v2u*)(HB + (size_t)m * DM) + lane;
#pragma unroll
                for (int j = 0; j < 8; ++j) { const v2u w = br[64 * j]; hr[64 * j] = (f32x4){__uint_as_float(w.x << 16), __uint_as_float(w.x & 0xffff0000u), __uint_as_float(w.y << 16), __uint_as_float(w.y & 0xffff0000u)} * rs * gr[64 * j]; } }
        } break;
        }
        if (ph + 1 < args.ph_hi) { asm volatile("s_waitcnt vmcnt(0) lgkmcnt(0)" ::: "memory"); if (args.ph_hi < 0) grid.sync(); else xcd_barrier(bar);     if (PROBE_DUP & 1) xcd_barrier(bar); }
    }
}

#ifndef MK_PER_PHASE
#define MK_PER_PHASE 0
#endif
extern "C" void kernel_launch(void* const* d_in, const int* in_sizes, int n_in, void* d_out, int out_size, void* d_ws, size_t ws_size, hipStream_t stream) {
    static int grid = 0;
    if (grid == 0) {
        if (n_in != 13 || in_sizes[0] != M * DM || out_size != M * DM || ws_size < WS_END) { fprintf(stderr, "kernel_launch: unexpected shapes (n_in %d in0 %d out %d ws %zu)\n", n_in, n_in > 0 ? in_sizes[0] : -1, out_size, ws_size); grid = -1; return; }
        int dev = 0, cus = 0, per_cu = 0;
        (void)hipGetDevice(&dev); (void)hipDeviceGetAttribute(&cus, hipDeviceAttributeMultiprocessorCount, dev);
        if (hipFuncSetAttribute((const void*)fwd_kernel, hipFuncAttributeMaxDynamicSharedMemorySize, LDS_BYTES) != hipSuccess) { fprintf(stderr, "kernel_launch: hipFuncSetAttribute failed\n"); grid = -1; return; }
        (void)hipOccupancyMaxActiveBlocksPerMultiprocessor(&per_cu, (const void*)fwd_kernel, NWAVES * 64, LDS_BYTES);
        if (per_cu < 1) { fprintf(stderr, "kernel_launch: occupancy query says %d\n", per_cu); per_cu = 1; }
        (void)hipGetLastError();
        grid = cus * per_cu;
    }
    if (grid < 0) return;
    if (hipMemsetAsync((char*)d_ws + WS_CTL, 0, CTL_ZERO_BYTES, stream) != hipSuccess) { fprintf(stderr, "kernel_launch: memset failed\n"); return; }
    Args a{};
    for (int i = 0; i < 13; ++i) a.in[i] = (const float*)d_in[i];
    a.in[13] = (const float*)d_out; a.in[14] = (const float*)d_ws;
#if MK_PER_PHASE
    for (int ph = 0; ph < NPHASE; ++ph) { a.ph_lo = ph; a.ph_hi = ph + 1; hipLaunchKernelGGL(fwd_kernel, dim3(grid), dim3(NWAVES * 64), LDS_BYTES, stream, a); }
#else
    a.ph_lo = 0; a.ph_hi = NPHASE + __builtin_popcount((unsigned)PROBE_DUP >> 1);
    void* kargs[] = {&a};
    hipError_t e = hipLaunchCooperativeKernel((const void*)fwd_kernel, dim3(grid), dim3(NWAVES * 64), kargs, LDS_BYTES, stream);
    if (e != hipSuccess) fprintf(stderr, "cooperative launch failed: %s (grid %d)\n", hipGetErrorString(e), grid);
#endif
}
```
